# Optimizing an MI355X kernel written in HIP

```python
import math, functools
import jax, jax.numpy as jnp
from jax import lax
import numpy as np

D_MODEL = 1024
BATCH = 16
SEQ = 256
DEPTH = 1
DEC_BATCH = 8
DEC_SEQ = 2048
PAST_LEN = 256

GRID_W = 64
GLA_HEADS = 4
GLA_DK = 128
GLA_DV = 256
GLA_QK = GLA_HEADS * GLA_DK
GLA_VW = GLA_HEADS * GLA_DV
GLA_RANK = 16
GLA_TAU = 16.0
CHUNK = 64
DIFF_HEADS = 8
DIFF_DH = 64
DIFF_QK = DIFF_HEADS * 2 * DIFF_DH
DIFF_VW = DIFF_HEADS * 2 * DIFF_DH
Q_BLOCK = 128
ROPE_BASE = 10000.0
ROPE_AXIS_DIM = DIFF_DH // 2
N_EXPERTS = 16
EXPERT_FF = 2816
CAPACITY_FACTOR = 2
EPS = 1e-6
IN_SIZES = (GLA_QK, GLA_QK, GLA_VW, GLA_VW, GLA_RANK, GLA_RANK, DIFF_QK, DIFF_QK, DIFF_VW, D_MODEL, D_MODEL)
IN_WIDTH = 2 * GLA_QK + 2 * GLA_VW + 2 * GLA_RANK + 2 * DIFF_QK + DIFF_VW + 2 * D_MODEL

kernel_name = 'hybrid_gla_diffattn_ec_dit_step'


def ln_plain(x):
    x32 = x.astype(jnp.float32)
    mu = jnp.mean(x32, axis=-1, keepdims=True)
    var = jnp.mean(jnp.square(x32 - mu), axis=-1, keepdims=True)
    return ((x32 - mu) * lax.rsqrt(var + EPS)).astype(x.dtype)


def ln_affine(x, g, b):
    x32 = x.astype(jnp.float32)
    mu = jnp.mean(x32, axis=-1, keepdims=True)
    var = jnp.mean(jnp.square(x32 - mu), axis=-1, keepdims=True)
    y = (x32 - mu) * lax.rsqrt(var + EPS) * g.astype(jnp.float32) + b.astype(jnp.float32)
    return y.astype(x.dtype)


def rms_norm(x, g):
    x32 = x.astype(jnp.float32)
    y = x32 * lax.rsqrt(jnp.mean(jnp.square(x32), axis=-1, keepdims=True) + EPS)
    return (y * g.astype(jnp.float32)).astype(x.dtype)


def grid_angles(n_tokens):
    rows = n_tokens // GRID_W
    pos_r = jnp.repeat(jnp.arange(rows, dtype=jnp.float32), GRID_W)
    pos_c = jnp.tile(jnp.arange(GRID_W, dtype=jnp.float32), rows)
    half = ROPE_AXIS_DIM // 2
    inv = ROPE_BASE ** (-jnp.arange(half, dtype=jnp.float32) / half)
    return pos_r[:, None] * inv, pos_c[:, None] * inv


def rope_half(x, ang):
    p = x.shape[-1] // 2
    cos = jnp.cos(ang)[None, :, None, None, :]
    sin = jnp.sin(ang)[None, :, None, None, :]
    x32 = x.astype(jnp.float32)
    x1, x2 = x32[..., :p], x32[..., p:]
    return jnp.concatenate([x1 * cos - x2 * sin, x1 * sin + x2 * cos], axis=-1).astype(x.dtype)


def axial_rope(x, ang_r, ang_c):
    return jnp.concatenate([rope_half(x[..., :ROPE_AXIS_DIM], ang_r),
                            rope_half(x[..., ROPE_AXIS_DIM:], ang_c)], axis=-1)


def gla_scan(q, k, v, log_a, s0):
    B, L, H, _ = q.shape
    dv = v.shape[-1]
    n = L // CHUNK

    def to_chunks(t):
        return jnp.moveaxis(t.astype(jnp.float32).reshape(B, n, CHUNK, H, t.shape[-1]), 1, 0)

    mask = jnp.tril(jnp.ones((CHUNK, CHUNK), dtype=bool))

    def step(S, inp):
        qc, kc, vc, gc = inp
        b = jnp.cumsum(gc, axis=1)
        b_last = b[:, -1]
        qe = qc * jnp.exp(b)
        ke = kc * jnp.exp(-b)
        o = jnp.einsum('bihk,bhkv->bihv', qe, S)
        A = jnp.where(mask, jnp.einsum('bihk,bjhk->bhij', qe, ke), 0.0)
        o = o + jnp.einsum('bhij,bjhv->bihv', A, vc)
        kd = kc * jnp.exp(b_last[:, None] - b)
        S = jnp.exp(b_last)[..., None] * S + jnp.einsum('bjhk,bjhv->bhkv', kd, vc)
        return S, o

    S, o = lax.scan(step, s0.astype(jnp.float32), (to_chunks(q), to_chunks(k), to_chunks(v), to_chunks(log_a)))
    o = jnp.moveaxis(o, 0, 1).reshape(B, L, H, dv)
    return o.astype(v.dtype), S


def diff_attention(q, k, v, lam):
    B, Lq, H, _, dh = q.shape
    nb = Lq // Q_BLOCK
    qb = jnp.moveaxis(q.reshape(B, nb, Q_BLOCK, H, 2, dh), 1, 0)
    scale = dh ** -0.5

    def block(qi):
        s = jnp.einsum('bqhcd,bkhcd->bhcqk', qi, k).astype(jnp.float32) * scale
        p = jax.nn.softmax(s, axis=-1)
        pd = (p[:, :, 0] - lam * p[:, :, 1]).astype(v.dtype)
        return jnp.einsum('bhqk,bkhe->bqhe', pd, v)

    o = lax.map(block, qb)
    return jnp.moveaxis(o, 0, 1).reshape(B, Lq, H, v.shape[-1])


def token_mixers(h, w_in, w_alpha_f, b_alpha_f, w_alpha_b, b_alpha_b, gla_norm_g, w_proj_a,
                 lam, lam_init, subln_g, w_proj_b, w_out, rope_ang, s0_f, s0_b, k_ctx, v_ctx):
    B, L, _ = h.shape
    offs, acc = [], 0
    for s in IN_SIZES[:-1]:
        acc += s
        offs.append(acc)
    qa, ka, va, ra, af, ab, qd, kd, vd, ga, gb = jnp.split(h @ w_in, offs, axis=-1)
    qa = qa.reshape(B, L, GLA_HEADS, GLA_DK) * (GLA_DK ** -0.5)
    ka = ka.reshape(B, L, GLA_HEADS, GLA_DK)
    va = va.reshape(B, L, GLA_HEADS, GLA_DV)
    log_f = (jax.nn.log_sigmoid((af @ w_alpha_f + b_alpha_f).astype(jnp.float32)) / GLA_TAU).reshape(B, L, GLA_HEADS, GLA_DK)
    log_b = (jax.nn.log_sigmoid((ab @ w_alpha_b + b_alpha_b).astype(jnp.float32)) / GLA_TAU).reshape(B, L, GLA_HEADS, GLA_DK)
    o_f, s_f = gla_scan(qa, ka, va, log_f, s0_f)
    o_b, s_b = gla_scan(jnp.flip(qa, 1), jnp.flip(ka, 1), jnp.flip(va, 1), jnp.flip(log_b, 1), s0_b)
    o_a = rms_norm(o_f + jnp.flip(o_b, 1), gla_norm_g) * jax.nn.silu(ra.reshape(B, L, GLA_HEADS, GLA_DV))
    o_a = o_a.reshape(B, L, GLA_VW)
    qd = qd.reshape(B, L, DIFF_HEADS, 2, DIFF_DH)
    kd = kd.reshape(B, L, DIFF_HEADS, 2, DIFF_DH)
    vd = vd.reshape(B, L, DIFF_HEADS, 2 * DIFF_DH)
    q_att, k_att, v_att = qd, kd, vd
    if rope_ang is not None:
        q_att = axial_rope(qd, rope_ang[0], rope_ang[1])
        k_att = axial_rope(kd, rope_ang[0], rope_ang[1])
    if k_ctx is not None:
        k_att = jnp.concatenate([k_att, k_ctx.astype(k_att.dtype)], axis=1)
        v_att = jnp.concatenate([v_att, v_ctx.astype(v_att.dtype)], axis=1)
    o_d = diff_attention(q_att, k_att, v_att, lam)
    o_d = (rms_norm(o_d, subln_g) * (1.0 - lam_init)).reshape(B, L, DIFF_VW)
    merged = jax.nn.sigmoid(ga) * (o_a @ w_proj_a) + jax.nn.sigmoid(gb) * (o_d @ w_proj_b)
    return merged @ w_out, kd, vd, s_f, s_b


def ec_moe(h, w_router, w_gate, w_up, w_down):
    B, L, D = h.shape
    n = B * L
    xt = h.reshape(n, D)
    aff = jax.nn.softmax((xt @ w_router).astype(jnp.float32), axis=-1)
    cap = CAPACITY_FACTOR * n // N_EXPERTS
    gate, idx = lax.top_k(aff.T, cap)
    xe = jnp.take(xt, idx, axis=0)
    hid = jax.nn.silu(jnp.einsum('ecd,edf->ecf', xe, w_gate)) * jnp.einsum('ecd,edf->ecf', xe, w_up)
    ye = jnp.einsum('ecf,efd->ecd', hid, w_down) * gate[..., None].astype(h.dtype)
    out = jnp.zeros_like(xt).at[idx.reshape(-1)].add(ye.reshape(-1, D))
    return out.reshape(B, L, D)


def trunk_layer(x, mod, mixer, moe, ln1_g, ln1_b, ln2_g, ln2_b, alpha, rope_ang, s0_f, s0_b, k_ctx, v_ctx):
    sh1, sc1, g1, sh2, sc2, g2 = jnp.split(mod[:, None, :].astype(x.dtype), 6, axis=-1)
    h = ln_plain(x) * (1 + sc1) + sh1
    mix, kd, vd, s_f, s_b = mixer(h, rope_ang=rope_ang, s0_f=s0_f, s0_b=s0_b, k_ctx=k_ctx, v_ctx=v_ctx)
    x = ln_affine(alpha * x + g1 * mix, ln1_g, ln1_b)
    h = ln_plain(x) * (1 + sc2) + sh2
    x = ln_affine(alpha * x + g2 * moe(h), ln2_g, ln2_b)
    return x, kd, vd, s_f, s_b


def setup_inputs(seed: int = 0) -> dict:
    key = jax.random.key(seed)
    ks = jax.random.split(key, 40)
    D = D_MODEL
    beta = (8.0 * DEPTH) ** -0.25

    def nrm(k, shape, s):
        return jax.random.normal(k, shape, jnp.float32) * s

    return {
        'x_prompt': nrm(ks[0], (BATCH, SEQ, D), 1.0),
        'x_sample': nrm(ks[1], (DEC_BATCH, DEC_SEQ, D), 1.0),
        'cache_diff_k': nrm(ks[2], (DEC_BATCH, DEPTH, PAST_LEN, DIFF_HEADS, 2, DIFF_DH), 1.0),
        'cache_diff_v': nrm(ks[3], (DEC_BATCH, DEPTH, PAST_LEN, DIFF_HEADS, 2 * DIFF_DH), 1.0),
        'state_gla_fwd': nrm(ks[4], (DEC_BATCH, DEPTH, GLA_HEADS, GLA_DK, GLA_DV), 0.1),
        'state_gla_bwd': nrm(ks[5], (DEC_BATCH, DEPTH, GLA_HEADS, GLA_DK, GLA_DV), 0.1),
        'c': nrm(ks[6], (DEC_BATCH, D), 1.0),
        'c_ctx': nrm(ks[7], (D,), 1.0),
        'w_mod': nrm(ks[8], (DEPTH, D, 6 * D), 0.5 * D ** -0.5),
        'b_mod': nrm(ks[9], (DEPTH, 6 * D), 0.02),
        'w_in': nrm(ks[10], (DEPTH, D, IN_WIDTH), D ** -0.5),
        'w_alpha_f': nrm(ks[11], (DEPTH, GLA_RANK, GLA_QK), GLA_RANK ** -0.5),
        'b_alpha_f': nrm(ks[12], (DEPTH, GLA_QK), 0.02),
        'w_alpha_b': nrm(ks[13], (DEPTH, GLA_RANK, GLA_QK), GLA_RANK ** -0.5),
        'b_alpha_b': nrm(ks[14], (DEPTH, GLA_QK), 0.02),
        'gla_norm_g': 1.0 + nrm(ks[15], (DEPTH, GLA_DV), 0.02),
        'w_proj_a': nrm(ks[16], (DEPTH, GLA_VW, D), GLA_VW ** -0.5),
        'lambda_q1': nrm(ks[17], (DEPTH, DIFF_DH), 0.1),
        'lambda_k1': nrm(ks[18], (DEPTH, DIFF_DH), 0.1),
        'lambda_q2': nrm(ks[19], (DEPTH, DIFF_DH), 0.1),
        'lambda_k2': nrm(ks[20], (DEPTH, DIFF_DH), 0.1),
        'subln_g': 1.0 + nrm(ks[21], (DEPTH, 2 * DIFF_DH), 0.02),
        'w_proj_b': nrm(ks[22], (DEPTH, DIFF_VW, D), DIFF_VW ** -0.5),
        'w_out': nrm(ks[23], (DEPTH, D, D), beta * D ** -0.5),
        'ln1_g': 1.0 + nrm(ks[24], (DEPTH, D), 0.02),
        'ln1_b': nrm(ks[25], (DEPTH, D), 0.02),
        'w_router': nrm(ks[26], (DEPTH, D, N_EXPERTS), D ** -0.5),
        'w_exp_gate': nrm(ks[27], (DEPTH, N_EXPERTS, D, EXPERT_FF), D ** -0.5),
        'w_exp_up': nrm(ks[28], (DEPTH, N_EXPERTS, D, EXPERT_FF), D ** -0.5),
        'w_exp_down': nrm(ks[29], (DEPTH, N_EXPERTS, EXPERT_FF, D), beta * EXPERT_FF ** -0.5),
        'ln2_g': 1.0 + nrm(ks[30], (DEPTH, D), 0.02),
        'ln2_b': nrm(ks[31], (DEPTH, D), 0.02),
    }


def reference(x_prompt, x_sample, cache_diff_k, cache_diff_v, state_gla_fwd, state_gla_bwd, c, c_ctx,
              w_mod, b_mod, w_in, w_alpha_f, b_alpha_f, w_alpha_b, b_alpha_b, gla_norm_g, w_proj_a,
              lambda_q1, lambda_k1, lambda_q2, lambda_k2, subln_g, w_proj_b, w_out, ln1_g, ln1_b,
              w_router, w_exp_gate, w_exp_up, w_exp_down, ln2_g, ln2_b):
    alpha = (2.0 * DEPTH) ** 0.25
    ang_r, ang_c = grid_angles(x_sample.shape[1])
    xp, xs = x_prompt, x_sample
    new_k, new_v, new_f, new_b = [], [], [], []
    for l in range(DEPTH):
        lam_init = 0.8 - 0.6 * math.exp(-0.3 * l)
        lam = (jnp.exp(jnp.sum(lambda_q1[l].astype(jnp.float32) * lambda_k1[l].astype(jnp.float32)))
               - jnp.exp(jnp.sum(lambda_q2[l].astype(jnp.float32) * lambda_k2[l].astype(jnp.float32)))
               + lam_init)
        mixer = functools.partial(token_mixers, w_in=w_in[l], w_alpha_f=w_alpha_f[l], b_alpha_f=b_alpha_f[l],
                                  w_alpha_b=w_alpha_b[l], b_alpha_b=b_alpha_b[l], gla_norm_g=gla_norm_g[l],
                                  w_proj_a=w_proj_a[l], lam=lam, lam_init=lam_init, subln_g=subln_g[l],
                                  w_proj_b=w_proj_b[l], w_out=w_out[l])
        moe = functools.partial(ec_moe, w_router=w_router[l], w_gate=w_exp_gate[l],
                                w_up=w_exp_up[l], w_down=w_exp_down[l])
        mod_ctx = jax.nn.silu(c_ctx)[None, :] @ w_mod[l] + b_mod[l]
        mod_lat = jax.nn.silu(c) @ w_mod[l] + b_mod[l]
        zeros = jnp.zeros((xp.shape[0], GLA_HEADS, GLA_DK, GLA_DV), jnp.float32)
        xp, kd, vd, s_f, s_b = trunk_layer(xp, mod_ctx, mixer, moe, ln1_g[l], ln1_b[l], ln2_g[l], ln2_b[l], alpha,
                                           rope_ang=None, s0_f=zeros, s0_b=zeros, k_ctx=None, v_ctx=None)
        new_k.append(kd)
        new_v.append(vd)
        new_f.append(s_f)
        new_b.append(s_b)
        xs = trunk_layer(xs, mod_lat, mixer, moe, ln1_g[l], ln1_b[l], ln2_g[l], ln2_b[l], alpha,
                         rope_ang=(ang_r, ang_c), s0_f=state_gla_fwd[:, l], s0_b=state_gla_bwd[:, l],
                         k_ctx=cache_diff_k[:, l], v_ctx=cache_diff_v[:, l])[0]
    new_diff_k = jnp.stack(new_k, axis=1)
    new_diff_v = jnp.stack(new_v, axis=1)
    new_gla_fwd = jnp.stack(new_f, axis=1)
    new_gla_bwd = jnp.stack(new_b, axis=1)
    return (xp, xs, new_diff_k, new_diff_v, new_gla_fwd, new_gla_bwd)
```

```cpp
#ifndef DBG_ZERO_MASK
#endif
#include <hip/hip_runtime.h>
#include <hip/hip_cooperative_groups.h>
#include <cstdio>
#include <cstdint>
namespace cg = cooperative_groups;

#define LAS __attribute__((address_space(3)))
typedef unsigned short bf16_t;
typedef short bf16x8 __attribute__((ext_vector_type(8)));
typedef short s16x4 __attribute__((ext_vector_type(4)));
typedef float f32x2 __attribute__((ext_vector_type(2)));
typedef float f32x4 __attribute__((ext_vector_type(4)));
typedef float f32x16 __attribute__((ext_vector_type(16)));
typedef unsigned u32x2 __attribute__((ext_vector_type(2)));
typedef unsigned u32x4 __attribute__((ext_vector_type(4)));

constexpr int D = 1024, NP = 4096, NS = 16384, NTOK = 20480, SEQ_P = 256, SEQ_S = 2048, PAST = 256;
constexpr int INW = 8224, FF = 2816, NE = 16, CAP_P = 512, CAP_S = 2048, SLOTS_E = 2560, NSLOT = NE * SLOTS_E;
constexpr float LN_EPS = 1e-6f;
constexpr int NTHREADS = 512, NWAVES = 8;
constexpr int LDS_BYTES = 147456;

enum { I_XP = 0, I_XS, I_CK, I_CV, I_SF, I_SB, I_C, I_CCTX, I_WMOD, I_BMOD, I_WIN, I_WAF, I_BAF, I_WAB, I_BAB, I_GLAG, I_WPA,
       I_LQ1, I_LK1, I_LQ2, I_LK2, I_SUBG, I_WPB, I_WOUT, I_LN1G, I_LN1B, I_WR, I_WEG, I_WEU, I_WED, I_LN2G, I_LN2B };

constexpr size_t O_YP = 0, O_YS = (size_t)NP * D, O_NK = (size_t)NTOK * D, O_NV = O_NK + (size_t)NP * D, O_NF = O_NV + (size_t)NP * D,
                 O_NB = O_NF + (size_t)16 * 4 * 128 * 256, O_END = O_NB + (size_t)16 * 4 * 128 * 256;

constexpr size_t al256(size_t x) { return (x + 255) / 256 * 256; }
constexpr size_t WS_CTL = 0;
constexpr size_t WS_MOD = 65536;
constexpr size_t WS_ROPE = WS_MOD + al256(9 * 6144 * 4 + 256);
constexpr size_t WS_AFAB = WS_ROPE + al256(3072 * 4);
constexpr size_t WS_AFF = WS_AFAB + (size_t)NTOK * 32 * 4;
constexpr size_t WS_SEL = WS_AFF + (size_t)NTOK * 16 * 4;
constexpr size_t WS_LIST = WS_SEL + (size_t)NTOK * 16 * 4;
constexpr size_t WS_GATE = WS_LIST + (size_t)NSLOT * 4;
constexpr size_t WS_CK = WS_GATE + (size_t)NSLOT * 4;
constexpr size_t WS_CV = WS_CK + (size_t)8 * 256 * 1024 * 2;
constexpr size_t WS_WIN = WS_CV + (size_t)8 * 256 * 1024 * 2;
constexpr size_t WS_WA = WS_WIN + (size_t)8192 * 1024 * 2;
constexpr size_t WS_WB = WS_WA + (size_t)1024 * 1024 * 2;
constexpr size_t WS_WO = WS_WB + (size_t)1024 * 1024 * 2;
constexpr size_t WS_WGU = WS_WO + (size_t)1024 * 1024 * 2;
constexpr size_t WS_A = WS_WGU + (size_t)16 * 5632 * 1024 * 2;
constexpr size_t SZ_T = (size_t)NTOK * 1024 * 2;
constexpr size_t WS_QA = WS_A, WS_KA = WS_QA + SZ_T / 2, WS_VA = WS_KA + SZ_T / 2, WS_QD = WS_VA + SZ_T, WS_KD = WS_QD + SZ_T,
                 WS_VD = WS_KD + SZ_T, WS_RA = WS_VD + SZ_T, WS_GA = WS_RA + SZ_T, WS_GB = WS_GA + SZ_T, WS_A_END = WS_GB + SZ_T;
constexpr size_t WS_OAN = WS_QD, WS_MRG = WS_KD, WS_H2 = WS_GA, WS_HID = WS_A;
constexpr size_t WS_C = WS_A_END;
constexpr size_t WS_OF = WS_C, WS_OB = WS_OF + SZ_T, WS_ODN = WS_OB + SZ_T, WS_END = WS_ODN + SZ_T;
constexpr size_t WS_WD = WS_C;
constexpr size_t WS_YE = WS_WGU;
static_assert((size_t)NSLOT * FF * 2 <= WS_H2 - WS_A, "hid overlaps h2");
static_assert((size_t)16 * 1024 * FF * 2 <= WS_END - WS_C, "w_down does not fit region C");
static_assert((size_t)2 * NSLOT * 1024 * 2 <= (size_t)16 * 5632 * 1024 * 2, "ye does not fit");

struct Params { const float* in[32]; float* out; unsigned char* ws; };

typedef __bf16 bf16x2_t __attribute__((ext_vector_type(2)));
__device__ __forceinline__ unsigned cvt_pk_bf16(float lo, float hi) { const f32x2 v = {lo, hi}; return __builtin_bit_cast(unsigned, __builtin_convertvector(v, bf16x2_t)); }
__device__ __forceinline__ float bf2f(unsigned short b) { return __uint_as_float(((unsigned)b) << 16); }
__device__ __forceinline__ float bflo(unsigned w) { return __uint_as_float(w << 16); }
__device__ __forceinline__ float bfhi(unsigned w) { return __uint_as_float(w & 0xffff0000u); }
__device__ __forceinline__ float wave_sum(float v) {
#pragma unroll
    for (int o = 1; o < 64; o <<= 1) v += __shfl_xor(v, o);
    return v;
}
__device__ __forceinline__ float sigmoidf_(float x) { return 1.0f / (1.0f + __expf(-x)); }
__device__ __forceinline__ float siluf_(float x) { return x / (1.0f + __expf(-x)); }
#define LDS_WAIT() asm volatile("s_waitcnt lgkmcnt(0)" ::: "memory")

struct Frame {
    LAS unsigned char* lds;
    int tid, lane, wave, vcu, G;
    const Params* p;
};

__device__ __forceinline__ void transpose_item(const float* __restrict__ W, size_t ldn, bf16_t* __restrict__ WT, size_t ldk, int k0, int nsrc0, size_t drow0, LAS float* scr, int lane) {
#pragma unroll 8
    for (int i = 0; i < 32; ++i) { const int kk = 2 * i + (lane >> 5); scr[kk * 33 + (lane & 31)] = W[(size_t)(k0 + kk) * ldn + nsrc0 + (lane & 31)]; }
    LDS_WAIT(); asm volatile("" ::: "memory");
    const int c = lane & 7;
#pragma unroll
    for (int j = 0; j < 4; ++j) { const int n = (lane >> 3) + 8 * j; const LAS float* s = scr + (8 * c) * 33 + n;
        u32x4 o; o.x = cvt_pk_bf16(s[0 * 33], s[1 * 33]); o.y = cvt_pk_bf16(s[2 * 33], s[3 * 33]); o.z = cvt_pk_bf16(s[4 * 33], s[5 * 33]); o.w = cvt_pk_bf16(s[6 * 33], s[7 * 33]);
        *(u32x4*)(WT + (drow0 + n) * ldk + k0 + 8 * c) = o; }
    LDS_WAIT(); asm volatile("" ::: "memory");
}

__device__ __forceinline__ void p0_prologue(Frame& F) {
    const Params& P = *F.p;
    unsigned char* ws = P.ws;
    LAS float* ldsf = (LAS float*)F.lds;
    const int c = F.vcu;
    if (c < 192) {
        const float* cc = P.in[I_C]; const float* cctx = P.in[I_CCTX]; const float* wm = P.in[I_WMOD]; const float* bm = P.in[I_BMOD];
        for (int i = F.tid; i < 9 * 1024; i += NTHREADS) { const int r = i >> 10, k = i & 1023; const float v = (r == 0) ? cctx[k] : cc[(r - 1) * 1024 + k]; ldsf[i] = siluf_(v); }
        __syncthreads();
        const int col = F.tid & 31, kg = F.tid >> 5, k0 = kg * 64;
        float acc[9];
#pragma unroll
        for (int r = 0; r < 9; ++r) acc[r] = 0.f;
#pragma unroll 4
        for (int kk = 0; kk < 64; ++kk) { const int k = k0 + kk; const float w = wm[(size_t)k * 6144 + 32 * c + col];
#pragma unroll
            for (int r = 0; r < 9; ++r) acc[r] = fmaf(ldsf[r * 1024 + k], w, acc[r]); }
        LAS float* red = ldsf + 9 * 1024;
#pragma unroll
        for (int r = 0; r < 9; ++r) red[(kg * 9 + r) * 32 + col] = acc[r];
        __syncthreads();
        if (F.tid < 288) { const int r = F.tid >> 5, cl = F.tid & 31; float s = 0.f;
#pragma unroll
            for (int g = 0; g < 16; ++g) s += red[(g * 9 + r) * 32 + cl];
            ((float*)(ws + WS_MOD))[r * 6144 + 32 * c + cl] = s + bm[32 * c + cl]; }
        __syncthreads();
    } else if (c == 192) {
        if (F.wave == 0) {
            const float* q1 = P.in[I_LQ1]; const float* k1 = P.in[I_LK1]; const float* q2 = P.in[I_LQ2]; const float* k2 = P.in[I_LK2];
            const float s1 = wave_sum(q1[F.lane] * k1[F.lane]), s2 = wave_sum(q2[F.lane] * k2[F.lane]);
            if (F.lane == 0) ((float*)(ws + WS_MOD))[9 * 6144] = expf(s1) - expf(s2) + 0.2f;
        }
        float* rope = (float*)(ws + WS_ROPE);
        for (int i = F.tid; i < 96 * 16; i += NTHREADS) {
            const int pos = i >> 4, j = i & 15;
            const float inv = powf(10000.0f, -(float)j / 16.0f);
            const float p = (pos < 32) ? (float)pos : (float)(pos - 32);
            float sn, cs; sincosf(p * inv, &sn, &cs);
            if (pos < 32) { rope[pos * 16 + j] = cs; rope[512 + pos * 16 + j] = sn; }
            else { rope[1024 + (pos - 32) * 16 + j] = cs; rope[2048 + (pos - 32) * 16 + j] = sn; }
        }
    }
    {
        LAS float* scr = ldsf + F.wave * (64 * 33);
        const int gw = F.vcu * NWAVES + F.wave, NGW = F.G * NWAVES;
        constexpr int I_IN = 16 * 256, I_PR = 16 * 32, I_EX = 16 * 16 * 88;
        constexpr int NIT = I_IN + 3 * I_PR + 2 * I_EX;
        for (int it = gw; it < NIT; it += NGW) {
            int r = it;
            if (r < I_IN) { const int kb = r >> 8, nb = r & 255, n0 = 32 * nb; transpose_item(P.in[I_WIN], INW, (bf16_t*)(ws + WS_WIN), 1024, 64 * kb, n0 + (n0 >= 3072 ? 32 : 0), (size_t)n0, scr, F.lane); continue; }
            r -= I_IN;
            if (r < 3 * I_PR) { const int w = r / I_PR, q = r % I_PR, kb = q >> 5, nb = q & 31;
                const float* src = (w == 0) ? P.in[I_WPA] : (w == 1) ? P.in[I_WPB] : P.in[I_WOUT];
                bf16_t* dst = (bf16_t*)(ws + ((w == 0) ? WS_WA : (w == 1) ? WS_WB : WS_WO));
                transpose_item(src, 1024, dst, 1024, 64 * kb, 32 * nb, (size_t)(32 * nb), scr, F.lane); continue; }
            r -= 3 * I_PR;
            { const int up = r / I_EX, q = r % I_EX, e = q / (16 * 88), q2 = q % (16 * 88), kb = q2 / 88, nb = q2 % 88, f0 = 32 * nb;
              const float* src = (up ? P.in[I_WEU] : P.in[I_WEG]) + (size_t)e * 1024 * FF;
              transpose_item(src, FF, (bf16_t*)(ws + WS_WGU), 1024, 64 * kb, f0, (size_t)e * 5632 + (size_t)(f0 >> 7) * 256 + (f0 & 127) + (up ? 128 : 0), scr, F.lane); }
        }
    }
    {
        const size_t n8 = (size_t)8 * 256 * 1024 / 8;
        for (size_t i = (size_t)F.vcu * NTHREADS + F.tid; i < 2 * n8; i += (size_t)F.G * NTHREADS) {
            const bool isk = i < n8; const size_t j = isk ? i : i - n8;
            const float* src = (isk ? P.in[I_CK] : P.in[I_CV]) + j * 8;
            const f32x4 a = *(const f32x4*)src, b = *(const f32x4*)(src + 4);
            u32x4 o; o.x = cvt_pk_bf16(a.x, a.y); o.y = cvt_pk_bf16(a.z, a.w); o.z = cvt_pk_bf16(b.x, b.y); o.w = cvt_pk_bf16(b.z, b.w);
            *(u32x4*)(ws + (isk ? WS_CK : WS_CV) + j * 16) = o;
        }
    }
}

__device__ __forceinline__ const float* xrow_ptr(const Params& P, int m) { return (m < NP) ? P.in[I_XP] + (size_t)m * D : P.in[I_XS] + (size_t)(m - NP) * D; }
__device__ __forceinline__ int mod_row(int m) { return (m < NP) ? 0 : 1 + ((m - NP) >> 11); }

__device__ __forceinline__ void p1_ln0(Frame& F) {
    const Params& P = *F.p;
    LAS float* wT = (LAS float*)F.lds;
    const float* win = P.in[I_WIN];
    for (int i = F.tid; i < 1024 * 32; i += NTHREADS) { const int k = i >> 5, c = i & 31; wT[c * 1028 + k] = win[(size_t)k * INW + 3072 + c]; }
    __syncthreads();
    const float* mod = (const float*)(P.ws + WS_MOD);
    bf16_t* H = (bf16_t*)P.out;
    float* afab = (float*)(P.ws + WS_AFAB);
    const int gw = F.vcu * NWAVES + F.wave, NGW = F.G * NWAVES, lane = F.lane;
    for (int pr = gw; pr < NTOK / 2; pr += NGW) {
        const int m0 = 2 * pr, mr = mod_row(m0);
        f32x4 h[2][4];
#pragma unroll
        for (int rr = 0; rr < 2; ++rr) {
            const f32x4* xr = (const f32x4*)xrow_ptr(P, m0 + rr) + lane;
            float s = 0.f;
#pragma unroll
            for (int j = 0; j < 4; ++j) { h[rr][j] = xr[64 * j]; s += (h[rr][j].x + h[rr][j].y) + (h[rr][j].z + h[rr][j].w); }
            const float mean = wave_sum(s) * (1.f / D); float s2 = 0.f;
#pragma unroll
            for (int j = 0; j < 4; ++j) { h[rr][j] = h[rr][j] - mean; s2 += (h[rr][j].x * h[rr][j].x + h[rr][j].y * h[rr][j].y) + (h[rr][j].z * h[rr][j].z + h[rr][j].w * h[rr][j].w); }
            const float rstd = 1.f / sqrtf(wave_sum(s2) * (1.f / D) + LN_EPS);
            u32x2* o8 = (u32x2*)(H + (size_t)(m0 + rr) * D) + lane;
#pragma unroll
            for (int j = 0; j < 4; ++j) {
                const f32x4 sh = *((const f32x4*)(mod + mr * 6144) + lane + 64 * j), sc = *((const f32x4*)(mod + mr * 6144 + 1024) + lane + 64 * j);
                h[rr][j] = h[rr][j] * rstd * (sc + 1.0f) + sh;
                u32x2 w; w.x = cvt_pk_bf16(h[rr][j].x, h[rr][j].y); w.y = cvt_pk_bf16(h[rr][j].z, h[rr][j].w); o8[64 * j] = w;
            }
        }
        float vals[64];
#pragma unroll
        for (int c = 0; c < 32; ++c) {
            float a0 = 0.f, a1 = 0.f;
#pragma unroll
            for (int j = 0; j < 4; ++j) { const f32x4 w = *((const LAS f32x4*)wT + c * 257 + lane + 64 * j);
                a0 += (h[0][j].x * w.x + h[0][j].y * w.y) + (h[0][j].z * w.z + h[0][j].w * w.w);
                a1 += (h[1][j].x * w.x + h[1][j].y * w.y) + (h[1][j].z * w.z + h[1][j].w * w.w); }
            vals[c] = a0; vals[32 + c] = a1;
            asm volatile("" ::: "memory");
        }
#define TR_STEP(O, HALF) { const bool up = (lane & (O)) != 0; _Pragma("unroll") for (int i = 0; i < (HALF); ++i) { const float a = vals[i], b = vals[i + (HALF)]; \
            const float send = up ? a : b, keep = up ? b : a; vals[i] = keep + __shfl_xor(send, (O)); } }
        TR_STEP(32, 32) TR_STEP(16, 16) TR_STEP(8, 8) TR_STEP(4, 4) TR_STEP(2, 2) TR_STEP(1, 1)
        afab[(size_t)m0 * 32 + lane] = vals[0];
    }
    __syncthreads();
}

namespace pg8 {
constexpr int BM = 256, BK = 64, HALF = 128, HTB = HALF * BK * 2, STAGE_BYTES = 8 * HTB, NXCD = 8, WGM = 8;
__device__ __forceinline__ int lds_byte(int r, int c) { const int st = (r >> 4) * 2 + (c >> 5), rr = r & 15, cc = c & 31, ob = rr * 64 + cc * 2; return st * 1024 + (ob ^ (((ob >> 9) & 1) << 5)); }
__device__ __forceinline__ void stage_rc(int b, int& R, int& C) { const int st = b / 1024, sb = b % 1024, swz = sb ^ (((sb >> 9) & 1) << 5); R = (st >> 1) * 16 + swz / 64; C = (st & 1) * 32 + (swz % 64) / 2; }
__device__ __forceinline__ int perm32(int rho) { const int n = rho >> 4, i = rho & 15; return 8 * (i >> 2) + 4 * n + (i & 3); }

template <class Sched, class Epi>
__device__ __forceinline__ void gemm_phase(LAS unsigned char* lds, const Sched& S, const Epi& E, const int tid) {
    const int wid = __builtin_amdgcn_readfirstlane(tid >> 6), lane = tid & 63, wr = wid >> 2, wc = wid & 3, fr = lane & 15, fq = lane >> 4;
    const int nt = S.nt;
    int Rr[2], Cc[2]; unsigned voffB[2];
#pragma unroll
    for (int i = 0; i < 2; ++i) { int R, C; stage_rc(tid * 16 + i * 8192, R, C); Rr[i] = R; Cc[i] = C; const int Rb = (R & ~31) + perm32(R & 31); voffB[i] = (unsigned)(Rb * S.ldb + C) * 2u; }
    const size_t kstep = (size_t)(BK * 2);
    const size_t hstepB = (size_t)HALF * S.ldb * 2;
    const unsigned ldsw = (unsigned)wid * 1024u;
    const int aoff = lds_byte(wr * 64 + fr, fq * 8), boff = lds_byte(wc * 32 + fr, fq * 8);
#define PG8_SA(b, h) (((b) * 2 + (h)) * HTB)
#define PG8_SB(b, h) ((4 + (b) * 2 + (h)) * HTB)
#define PG8_STAGE(bufoff, gbase, voff) do { _Pragma("unroll") for (int _i = 0; _i < 2; ++_i) \
        __builtin_amdgcn_global_load_lds((const unsigned*)((const char*)(gbase) + (voff)[_i]), (LAS unsigned*)(lds + (bufoff) + ldsw + _i * 8192), 16, 0, 0); } while (0)
#define PG8_LDA(dst, b, h) do { _Pragma("unroll") for (int m = 0; m < 4; ++m) _Pragma("unroll") for (int k = 0; k < 2; ++k) dst[m][k] = *(const LAS bf16x8*)(lds + PG8_SA(b, h) + aoff + m * 2048 + k * 1024); } while (0)
#define PG8_LDB(dst, b, h) do { _Pragma("unroll") for (int n = 0; n < 2; ++n) _Pragma("unroll") for (int k = 0; k < 2; ++k) dst[n][k] = *(const LAS bf16x8*)(lds + PG8_SB(b, h) + boff + n * 2048 + k * 1024); } while (0)
#define PG8_MMA(ai, bj, At, Bt) do { __builtin_amdgcn_s_setprio(1); _Pragma("unroll") for (int m = 0; m < 4; ++m) _Pragma("unroll") for (int n = 0; n < 2; ++n) _Pragma("unroll") for (int k = 0; k < 2; ++k) \
        acc[ai][bj][m][n] = __builtin_amdgcn_mfma_f32_16x16x32_bf16(Bt[n][k], At[m][k], acc[ai][bj][m][n], 0, 0, 0); __builtin_amdgcn_s_setprio(0); } while (0)
#define PG8_WAIT_V(n) asm volatile("s_waitcnt vmcnt(" #n ")" ::: "memory")
#define PG8_WAIT_L(n) asm volatile("s_waitcnt lgkmcnt(" #n ")" ::: "memory")
#define PG8_BAR __builtin_amdgcn_s_barrier()
#define PG8_SCHED __builtin_amdgcn_sched_barrier(0)
#define PG8_VOFFA(dst, u) do { _Pragma("unroll") for (int _h = 0; _h < 2; ++_h) _Pragma("unroll") for (int _i = 0; _i < 2; ++_i) \
        dst[_h][_i] = (unsigned)(S.a_row(u, _h * HALF + Rr[_i]) * (unsigned)S.lda + (unsigned)Cc[_i]) * 2u; } while (0)
    typename Sched::U cur, nxt; int ui = 0;
    if (!S.next(0, cur)) return;
    f32x4 acc[2][2][4][2];
#pragma unroll
    for (int a = 0; a < 2; ++a)
#pragma unroll
        for (int b = 0; b < 2; ++b)
#pragma unroll
            for (int m = 0; m < 4; ++m)
#pragma unroll
                for (int n = 0; n < 2; ++n) acc[a][b][m][n] = (f32x4){0.f, 0.f, 0.f, 0.f};
    bf16x8 At[4][2], B0[2][2], B1[2][2];
    unsigned vA[2][2], vAn[2][2];
    PG8_VOFFA(vA, cur);
    const char* cA = S.a_base(cur); const char* cB = S.b_base(cur);
    PG8_STAGE(PG8_SB(0, 0), cB, voffB); PG8_STAGE(PG8_SA(0, 0), cA, vA[0]); PG8_STAGE(PG8_SB(0, 1), cB + hstepB, voffB); PG8_STAGE(PG8_SA(0, 1), cA, vA[1]);
    if (wr == 1) PG8_BAR;
    PG8_WAIT_V(4); PG8_BAR;
    PG8_STAGE(PG8_SB(1, 0), cB + kstep, voffB); PG8_STAGE(PG8_SA(1, 0), cA + kstep, vA[0]); PG8_STAGE(PG8_SB(1, 1), cB + hstepB + kstep, voffB);
    PG8_WAIT_V(6); PG8_BAR;
    for (;;) {
        const bool has_next = S.next(ui + 1, nxt);
        const char* nA = has_next ? S.a_base(nxt) : cA; const char* nB = has_next ? S.b_base(nxt) : cB;
        if (has_next) { PG8_VOFFA(vAn, nxt); } else {
#pragma unroll
            for (int h = 0; h < 2; ++h)
#pragma unroll
                for (int i = 0; i < 2; ++i) vAn[h][i] = vA[h][i]; }
        for (int t = 0; t < nt; t += 2) {
            const bool last = (t == nt - 2);
            const char* a1 = cA + (size_t)(t + 1) * kstep;
            const char* a2 = last ? nA : cA + (size_t)(t + 2) * kstep; const char* b2 = last ? nB : cB + (size_t)(t + 2) * kstep;
            const char* a3 = a2 + kstep; const char* b3 = b2 + kstep;
            unsigned v2[2][2];
#pragma unroll
            for (int h = 0; h < 2; ++h)
#pragma unroll
                for (int i = 0; i < 2; ++i) v2[h][i] = last ? vAn[h][i] : vA[h][i];
            PG8_LDB(B0, 0, 0); PG8_SCHED; PG8_LDA(At, 0, 0); PG8_STAGE(PG8_SA(1, 1), a1, vA[1]);
            PG8_WAIT_L(8); PG8_BAR; PG8_WAIT_L(0); PG8_MMA(0, 0, At, B0); PG8_BAR; PG8_SCHED;
            PG8_LDB(B1, 0, 1); PG8_STAGE(PG8_SB(0, 0), b2, voffB);
            PG8_BAR; PG8_WAIT_L(0); PG8_MMA(0, 1, At, B1); PG8_BAR;
            PG8_LDA(At, 0, 1); PG8_STAGE(PG8_SA(0, 0), a2, v2[0]);
            PG8_BAR; PG8_WAIT_L(0); PG8_MMA(1, 0, At, B0); PG8_BAR; PG8_SCHED;
            PG8_STAGE(PG8_SB(0, 1), b2 + hstepB, voffB);
            PG8_WAIT_V(6); PG8_BAR; PG8_MMA(1, 1, At, B1); PG8_BAR;
            PG8_LDB(B0, 1, 0); PG8_SCHED; PG8_LDA(At, 1, 0); PG8_STAGE(PG8_SA(0, 1), a2, v2[1]);
            PG8_WAIT_L(8); PG8_BAR; PG8_WAIT_L(0); PG8_MMA(0, 0, At, B0); PG8_BAR; PG8_SCHED;
            PG8_LDB(B1, 1, 1); PG8_STAGE(PG8_SB(1, 0), b3, voffB);
            PG8_BAR; PG8_WAIT_L(0); PG8_MMA(0, 1, At, B1); PG8_BAR;
            PG8_LDA(At, 1, 1); PG8_STAGE(PG8_SA(1, 0), a3, v2[0]);
            PG8_BAR; PG8_WAIT_L(0); PG8_MMA(1, 0, At, B0); PG8_BAR; PG8_SCHED;
            PG8_STAGE(PG8_SB(1, 1), b3 + hstepB, voffB);
            PG8_WAIT_V(6); PG8_BAR; PG8_MMA(1, 1, At, B1); PG8_BAR;
        }
        E(acc, cur, wr, wc, fr, fq);
        if (!has_next) break;
#pragma unroll
        for (int a = 0; a < 2; ++a)
#pragma unroll
            for (int b = 0; b < 2; ++b)
#pragma unroll
                for (int m = 0; m < 4; ++m)
#pragma unroll
                    for (int n = 0; n < 2; ++n) acc[a][b][m][n] = (f32x4){0.f, 0.f, 0.f, 0.f};
        cur = nxt; cA = nA; cB = nB; ++ui;
#pragma unroll
        for (int h = 0; h < 2; ++h)
#pragma unroll
            for (int i = 0; i < 2; ++i) vA[h][i] = vAn[h][i];
    }
    PG8_WAIT_V(0);
    if (wr == 0) PG8_BAR;
    PG8_BAR;
#undef PG8_SA
#undef PG8_SB
#undef PG8_STAGE
#undef PG8_LDA
#undef PG8_LDB
#undef PG8_MMA
#undef PG8_WAIT_V
#undef PG8_WAIT_L
#undef PG8_BAR
#undef PG8_SCHED
#undef PG8_VOFFA
}

__device__ __forceinline__ bool static_tile(int nM, int nN, int G, int c, int i, int& pm, int& pn) {
    const int nwg = nM * nN; const long L = (long)i * G + c; if (L >= nwg) return false;
    int wgid = (int)L; { const int q = nwg / NXCD, r = nwg % NXCD, xcd = wgid % NXCD, off = wgid / NXCD; wgid = (xcd < r ? xcd * (q + 1) : r * (q + 1) + (xcd - r) * q) + off; }
    const int nig = WGM * nN, gid = wgid / nig, fm = gid * WGM, gsz = (nM - fm) < WGM ? (nM - fm) : WGM;
    pm = fm + ((wgid % nig) % gsz); pn = (wgid % nig) / gsz; return true;
}
}

struct SchedIn {
    struct U { int pm, pn; };
    const char* A; const char* B; int lda, ldb, nt, G, c;
    __device__ __forceinline__ bool next(int i, U& u) const { return pg8::static_tile(NTOK / 256, 32, G, c, i, u.pm, u.pn); }
    __device__ __forceinline__ const char* a_base(const U&) const { return A; }
    __device__ __forceinline__ unsigned a_row(const U& u, int r) const { return (unsigned)(u.pm * 256 + r); }
    __device__ __forceinline__ const char* b_base(const U& u) const { return B + (size_t)u.pn * 256 * ldb * 2; }
};
struct EpiIn {
    unsigned char* ws; float* out; const float* rope;
    __device__ __forceinline__ void operator()(const f32x4 (&acc)[2][2][4][2], const SchedIn::U& u, int wr, int wc, int fr, int fq) const {
        const int pn = u.pn; int kind, t0, width; size_t off;
        if (pn < 2) { kind = 0; t0 = 0; width = 512; off = WS_QA; } else if (pn < 4) { kind = 1; t0 = 2; width = 512; off = WS_KA; }
        else if (pn < 8) { kind = 1; t0 = 4; width = 1024; off = WS_VA; } else if (pn < 12) { kind = 2; t0 = 8; width = 1024; off = WS_RA; }
        else if (pn < 16) { kind = 3; t0 = 12; width = 1024; off = WS_QD; } else if (pn < 20) { kind = 4; t0 = 16; width = 1024; off = WS_KD; }
        else if (pn < 24) { kind = 5; t0 = 20; width = 1024; off = WS_VD; } else if (pn < 28) { kind = 6; t0 = 24; width = 1024; off = WS_GA; }
        else { kind = 6; t0 = 28; width = 1024; off = WS_GB; }
        bf16_t* base = (bf16_t*)(ws + off);
        const int row0 = u.pm * 256 + wr * 64 + fr, col0 = (pn - t0) * 256 + wc * 32 + 8 * fq;
        const bool prompt = u.pm < 16;
        const bool rope_on = (kind == 3 || kind == 4) && !prompt;
        const float sgn = (fq < 2) ? -1.f : 1.f;
#pragma unroll
        for (int ai = 0; ai < 2; ++ai)
#pragma unroll
            for (int m = 0; m < 4; ++m) {
                const int row = row0 + ai * 128 + m * 16;
                bf16_t* rowp = base + (size_t)row * width + col0;
                f32x4 cs0, cs1, sn0, sn1;
                if (rope_on) {
                    const int l = (row - NP) & 2047; const int pos = (wc & 1) ? (l & 63) : (l >> 6);
                    const float* tb = rope + ((wc & 1) ? 1024 : 0) + pos * 16 + 8 * (fq & 1);
                    const int so = (wc & 1) ? 1024 : 512;
                    cs0 = *(const f32x4*)tb; cs1 = *(const f32x4*)(tb + 4); sn0 = *(const f32x4*)(tb + so); sn1 = *(const f32x4*)(tb + so + 4);
                }
#pragma unroll
                for (int bj = 0; bj < 2; ++bj) {
                    f32x4 v0 = acc[ai][bj][m][0], v1 = acc[ai][bj][m][1];
                    if (kind == 0) { v0 = v0 * 0.08838834764831845f; v1 = v1 * 0.08838834764831845f; }
                    else if (kind == 2) {
#pragma unroll
                        for (int j = 0; j < 4; ++j) { v0[j] = siluf_(v0[j]); v1[j] = siluf_(v1[j]); } }
                    else if (kind == 6) {
#pragma unroll
                        for (int j = 0; j < 4; ++j) { v0[j] = sigmoidf_(v0[j]); v1[j] = sigmoidf_(v1[j]); } }
                    if ((kind == 4 || kind == 5) && prompt) {
                        float* o32 = out + (kind == 4 ? O_NK : O_NV) + (size_t)row * 1024 + col0 + bj * 128;
                        *(f32x4*)o32 = v0; *(f32x4*)(o32 + 4) = v1;
                    }
                    if (kind == 3 || kind == 4) {
                        f32x4 p0, p1;
#pragma unroll
                        for (int j = 0; j < 4; ++j) { p0[j] = __shfl_xor(v0[j], 32); p1[j] = __shfl_xor(v1[j], 32); }
                        if (rope_on) { v0 = v0 * cs0 + p0 * sn0 * sgn; v1 = v1 * cs1 + p1 * sn1 * sgn; }
                    }
                    u32x4 w; w.x = cvt_pk_bf16(v0[0], v0[1]); w.y = cvt_pk_bf16(v0[2], v0[3]); w.z = cvt_pk_bf16(v1[0], v1[1]); w.w = cvt_pk_bf16(v1[2], v1[3]);
                    *(u32x4*)(rowp + bj * 128) = w;
                }
            }
    }
};


namespace att {
constexpr float SCALE = 0.125f;
constexpr float THR = 8.f;
constexpr int SHM_V = 64 * 128 * 2, SHM_K = 64 * 128 * 2;
#define KSWZ(row, colB) ((row) * 256 + ((colB) ^ (((row) & 7) << 4)))
#define SBAR() __builtin_amdgcn_sched_barrier(0)
__device__ __forceinline__ int crow(int r, int hi) { return (r & 3) + 8 * (r >> 2) + 4 * hi; }
__device__ __forceinline__ void partialSM(f32x16& p0, f32x16& p1, float& m_reg, float& mn, float& alpha) {
  constexpr float C = SCALE * 1.4426950408889634f;
  float pmax = p0[0];
#pragma unroll
  for (int r = 1; r < 16; ++r) pmax = fmaxf(pmax, p0[r]);
#pragma unroll
  for (int r = 0; r < 16; ++r) pmax = fmaxf(pmax, p1[r]);
  { auto rr = __builtin_amdgcn_permlane32_swap(__float_as_uint(pmax), __float_as_uint(pmax), false, false);
    pmax = fmaxf(__uint_as_float(rr[0]), __uint_as_float(rr[1])); }
  if (__builtin_expect(__all(pmax - m_reg <= THR / SCALE), 1)) { mn = m_reg; alpha = 1.f; }
  else { mn = fmaxf(m_reg, pmax); alpha = __builtin_amdgcn_exp2f((m_reg - mn) * C); m_reg = mn; }
  const float mnC = -mn * C;
#pragma unroll
  for (int r = 0; r < 16; ++r) p0[r] = fmaf(p0[r], C, mnC);
#pragma unroll
  for (int r = 0; r < 16; ++r) p1[r] = fmaf(p1[r], C, mnC);
#pragma unroll
  for (int r = 0; r < 16; ++r) p0[r] = __builtin_amdgcn_exp2f(p0[r]);
}
__device__ __forceinline__ void finishSM(f32x16& p0, f32x16& p1, float alpha, float& l_reg, bf16x8& pa0, bf16x8& pa1, bf16x8& pa2, bf16x8& pa3) {
#pragma unroll
  for (int r = 0; r < 16; ++r) p1[r] = __builtin_amdgcn_exp2f(p1[r]);
  float ps = 0;
#pragma unroll
  for (int r = 0; r < 16; ++r) ps += p0[r];
#pragma unroll
  for (int r = 0; r < 16; ++r) ps += p1[r];
  { auto rr = __builtin_amdgcn_permlane32_swap(__float_as_uint(ps), __float_as_uint(ps), false, false);
    ps = __uint_as_float(rr[0]) + __uint_as_float(rr[1]); }
  l_reg = l_reg * alpha + ps;
#define PK4(P, BASE, OUT) do { unsigned a0 = cvt_pk_bf16(P[BASE + 0], P[BASE + 1]), a1 = cvt_pk_bf16(P[BASE + 2], P[BASE + 3]);   \
    unsigned b0 = cvt_pk_bf16(P[BASE + 4], P[BASE + 5]), b1 = cvt_pk_bf16(P[BASE + 6], P[BASE + 7]);                              \
    auto r0 = __builtin_amdgcn_permlane32_swap(a0, b0, false, false); auto r1 = __builtin_amdgcn_permlane32_swap(a1, b1, false, false); \
    u32x4 w = {r0[0], r1[0], r0[1], r1[1]}; OUT = __builtin_bit_cast(bf16x8, w); } while (0)
  PK4(p0, 0, pa0); PK4(p0, 8, pa1); PK4(p1, 0, pa2); PK4(p1, 8, pa3);
#undef PK4
}
__device__ __forceinline__ void qkt(f32x16& p0, f32x16& p1, const LAS char* Ks, const bf16x8* qr, int r32, int hi, int comp) {
#pragma unroll
  for (int r = 0; r < 16; ++r) { p0[r] = 0.f; p1[r] = 0.f; }
#pragma unroll
  for (int d0 = 0; d0 < 4; ++d0) { const int cb = (comp * 64 + d0 * 16 + hi * 8) * 2;
    const bf16x8 b0 = *(const LAS bf16x8*)(Ks + KSWZ(r32, cb));
    const bf16x8 b1 = *(const LAS bf16x8*)(Ks + KSWZ(32 + r32, cb));
    p0 = __builtin_amdgcn_mfma_f32_32x32x16_bf16(b0, qr[d0], p0, 0, 0, 0);
    p1 = __builtin_amdgcn_mfma_f32_32x32x16_bf16(b1, qr[d0], p1, 0, 0, 0); }
}
__device__ __forceinline__ int v_st(int k, int c) { const int kk = (k & ~0xC) | ((k & 4) << 1) | ((k & 8) >> 1); return ((kk >> 3) * 4 + (c >> 5)) * 512 + ((kk & 7) * 32 + (c & 31)) * 2; }
__device__ __forceinline__ int v_rd_base(int lane) { return ((lane & 3) << 3) | (((lane >> 2) & 3) << 6) | (((lane >> 4) & 1) << 5) | (((lane >> 5) & 1) << 8); }
constexpr int v_rd_off(int d0, int ks, int half) { return d0 * 512 + ks * 4096 + half * 2048; }
template <int OFF> __device__ __forceinline__ s16x4 tr_read(int vb) {
  s16x4 r; asm volatile("ds_read_b64_tr_b16 %0, %1 offset:%2" : "=&v"(r) : "v"(vb), "i"(OFF) : "memory"); return r;
}
template <int D0> __device__ __forceinline__ void pv_one(f32x16& od, int vb, bf16x8 pa0, bf16x8 pa1, bf16x8 pa2, bf16x8 pa3) {
  const s16x4 l0 = tr_read<v_rd_off(D0, 0, 0)>(vb), h0 = tr_read<v_rd_off(D0, 0, 1)>(vb), l1 = tr_read<v_rd_off(D0, 1, 0)>(vb), h1 = tr_read<v_rd_off(D0, 1, 1)>(vb);
  const s16x4 l2 = tr_read<v_rd_off(D0, 2, 0)>(vb), h2 = tr_read<v_rd_off(D0, 2, 1)>(vb), l3 = tr_read<v_rd_off(D0, 3, 0)>(vb), h3 = tr_read<v_rd_off(D0, 3, 1)>(vb);
  asm volatile("s_waitcnt lgkmcnt(0)" ::: "memory"); SBAR();
#define PK(L, H) (bf16x8){L[0], L[1], L[2], L[3], H[0], H[1], H[2], H[3]}
  od = __builtin_amdgcn_mfma_f32_32x32x16_bf16(pa0, PK(l0, h0), od, 0, 0, 0);
  od = __builtin_amdgcn_mfma_f32_32x32x16_bf16(pa1, PK(l1, h1), od, 0, 0, 0);
  od = __builtin_amdgcn_mfma_f32_32x32x16_bf16(pa2, PK(l2, h2), od, 0, 0, 0);
  od = __builtin_amdgcn_mfma_f32_32x32x16_bf16(pa3, PK(l3, h3), od, 0, 0, 0);
#undef PK
}
__device__ __forceinline__ void pv_d0(f32x16* o, int vb, bf16x8 pa0, bf16x8 pa1, bf16x8 pa2, bf16x8 pa3) {
  pv_one<0>(o[0], vb, pa0, pa1, pa2, pa3); pv_one<1>(o[1], vb, pa0, pa1, pa2, pa3); pv_one<2>(o[2], vb, pa0, pa1, pa2, pa3); pv_one<3>(o[3], vb, pa0, pa1, pa2, pa3);
}

struct Unit { const bf16_t* Q; const bf16_t* K0; const bf16_t* V0; const bf16_t* K1; const bf16_t* V1; bf16_t* O; int nt0, NT; };

__device__ __forceinline__ void unit_body(const Unit& U, LAS char* lds, float lam, const float* __restrict__ subg, const int tid) {
  constexpr int LD = 1024;
  const int wid = tid >> 6, lane = tid & 63, r32 = lane & 31, hi = lane >> 5, qs = wid >> 1, comp = wid & 1;
  LAS char* V_lds = lds; LAS char* K_lds = lds + 2 * SHM_V;
  LAS float* wsf = (LAS float*)(lds + 2 * SHM_V + 2 * SHM_K) + wid * 64; LAS float* li_l = wsf; LAS float* al_l = wsf + 32;
  float m_reg = -1e30f, l_reg = 0; f32x16 o[4]; bf16x8 qr[4];
#pragma unroll
  for (int d = 0; d < 4; ++d)
#pragma unroll
    for (int r = 0; r < 16; ++r) o[d][r] = 0.f;
  const bf16_t* Qw = U.Q + (size_t)(qs * 32 + r32) * LD + comp * 64 + hi * 8;
#pragma unroll
  for (int d0 = 0; d0 < 4; ++d0) qr[d0] = *(const bf16x8*)(Qw + d0 * 16);
  const int sr = tid >> 4, sc = (tid & 15) * 8, vst0 = v_st(sr, sc), vst1 = v_st(32 + sr, sc);
  const int vb0 = (int)(uintptr_t)V_lds + v_rd_base(lane);
  const unsigned so0 = (unsigned)(sr * LD + sc) * 2u, so1 = (unsigned)((32 + sr) * LD + sc) * 2u;
  struct { bf16x8 vs0, vs1, ks0, ks1; } sr_[2];
#define TILE_K(t) (((t) < U.nt0) ? U.K0 + (size_t)(t) * 64 * LD : U.K1 + (size_t)((t) - U.nt0) * 64 * LD)
#define TILE_V(t) (((t) < U.nt0) ? U.V0 + (size_t)(t) * 64 * LD : U.V1 + (size_t)((t) - U.nt0) * 64 * LD)
#define SLOAD(i, t) do { const char* _kb = (const char*)TILE_K(t); const char* _vb = (const char*)TILE_V(t); \
    sr_[i].vs0 = *(const bf16x8*)(_vb + so0); sr_[i].vs1 = *(const bf16x8*)(_vb + so1); \
    sr_[i].ks0 = *(const bf16x8*)(_kb + so0); sr_[i].ks1 = *(const bf16x8*)(_kb + so1); } while (0)
#define SWRITE(b, i) do { *(LAS bf16x8*)(V_lds + (b) * SHM_V + vst0) = sr_[i].vs0; *(LAS bf16x8*)(V_lds + (b) * SHM_V + vst1) = sr_[i].vs1; const int kc = sc * 2; \
    *(LAS bf16x8*)(K_lds + (b) * SHM_K + KSWZ(sr, kc)) = sr_[i].ks0; *(LAS bf16x8*)(K_lds + (b) * SHM_K + KSWZ(32 + sr, kc)) = sr_[i].ks1; } while (0)
#define SWAIT() asm volatile("s_waitcnt vmcnt(4)" ::: "memory")
#define RESC(a) do { if (__any((a) < 1.f)) { if (hi == 0) al_l[r32] = (a); asm volatile("s_waitcnt lgkmcnt(0)" ::: "memory"); \
    _Pragma("unroll") for (int d = 0; d < 4; ++d) _Pragma("unroll") for (int r = 0; r < 16; ++r) o[d][r] *= al_l[crow(r, hi)]; } } while (0)
  f32x16 pA0, pA1, pB0, pB1; float mnA, mnB, alA, alB; bf16x8 pa0, pa1, pa2, pa3; const int NT = U.NT;
  constexpr int SE = 0, SO = 1;
  SLOAD(SE, 0); asm volatile("s_waitcnt vmcnt(0)" ::: "memory"); SWRITE(0, SE); __syncthreads();
  qkt(pA0, pA1, K_lds, qr, r32, hi, comp); partialSM(pA0, pA1, m_reg, mnA, alA);
  SLOAD(SO, 1); if (2 < NT) SLOAD(SE, 2);
  SWAIT(); SWRITE(1, SO); __syncthreads();
  for (int j = 1; j + 1 < NT; j += 2) {
    SBAR(); qkt(pB0, pB1, K_lds + SHM_K, qr, r32, hi, comp);
    finishSM(pA0, pA1, alA, l_reg, pa0, pa1, pa2, pa3); SBAR();
    SLOAD(SO, j + 2); SBAR();
    pv_d0(o, vb0, pa0, pa1, pa2, pa3); partialSM(pB0, pB1, m_reg, mnB, alB);
    __syncthreads(); SWAIT(); SWRITE(0, SE);
    RESC(alB); __syncthreads();
    SBAR(); qkt(pA0, pA1, K_lds, qr, r32, hi, comp);
    finishSM(pB0, pB1, alB, l_reg, pa0, pa1, pa2, pa3); SBAR();
    if (j + 3 < NT) SLOAD(SE, j + 3); SBAR();
    pv_d0(o, vb0 + SHM_V, pa0, pa1, pa2, pa3); partialSM(pA0, pA1, m_reg, mnA, alA);
    __syncthreads(); SWAIT(); SWRITE(1, SO);
    RESC(alA); __syncthreads();
  }
  SBAR(); qkt(pB0, pB1, K_lds + SHM_K, qr, r32, hi, comp);
  finishSM(pA0, pA1, alA, l_reg, pa0, pa1, pa2, pa3); SBAR();
  pv_d0(o, vb0, pa0, pa1, pa2, pa3); partialSM(pB0, pB1, m_reg, mnB, alB);
  __syncthreads(); RESC(alB);
  finishSM(pB0, pB1, alB, l_reg, pa0, pa1, pa2, pa3); SBAR();
  pv_d0(o, vb0 + SHM_V, pa0, pa1, pa2, pa3);
  if (hi == 0) li_l[r32] = l_reg; asm volatile("s_waitcnt lgkmcnt(0)" ::: "memory");
  float rli[16];
#pragma unroll
  for (int r = 0; r < 16; ++r) rli[r] = 1.0f / li_l[crow(r, hi)];
  __syncthreads();
  LAS float* X = (LAS float*)lds + qs * 4096;
  if (comp == 1) {
#pragma unroll
    for (int d = 0; d < 4; ++d)
#pragma unroll
      for (int r = 0; r < 16; ++r) X[(d * 16 + r) * 64 + lane] = o[d][r] * rli[r] * lam;
  }
  __syncthreads();
  if (comp == 0) {
    float ss[16];
#pragma unroll
    for (int r = 0; r < 16; ++r) ss[r] = 0.f;
#pragma unroll
    for (int d = 0; d < 4; ++d)
#pragma unroll
      for (int r = 0; r < 16; ++r) { o[d][r] = o[d][r] * rli[r] - X[(d * 16 + r) * 64 + lane]; ss[r] += o[d][r] * o[d][r]; }
#pragma unroll
    for (int r = 0; r < 16; ++r) {
#pragma unroll
      for (int of = 1; of < 32; of <<= 1) ss[r] += __shfl_xor(ss[r], of);
      ss[r] = 0.8f / sqrtf(ss[r] * (1.f / 128.f) + LN_EPS);
    }
    bf16_t* Ow = U.O + (size_t)(qs * 32) * LD;
#pragma unroll
    for (int d = 0; d < 4; ++d) { const float g = subg[d * 32 + r32];
#pragma unroll
      for (int r = 0; r < 16; ++r) Ow[(size_t)crow(r, hi) * LD + d * 32 + r32] = (bf16_t)(cvt_pk_bf16(o[d][r] * ss[r] * g, 0.f) & 0xffffu); }
  }
  __syncthreads();
#undef TILE_K
#undef TILE_V
#undef SLOAD
#undef SWRITE
#undef SWAIT
#undef RESC
}
}

namespace gla {
constexpr int G_QE = 0, G_KE = 17408, G_KDT = 34816, G_VT = 53248, G_AF = 90112, G_TOT = 94208, G_EBL = 96256, G_WA = 96768, G_VR = 105472;
__device__ __forceinline__ int crow(int r, int hi) { return (r & 3) + 8 * (r >> 2) + 4 * hi; }
__device__ __forceinline__ int qe_addr(int row, int pos) { return row * 272 + pos * 2; }
__device__ __forceinline__ int t_addr(int row, int chunk) { return row * 144 + chunk * 16; }
__device__ __forceinline__ constexpr int swz23(int x) { return (x & ~12) | ((x & 4) << 1) | ((x & 8) >> 1); }
__device__ __forceinline__ bf16x8 pack8(const f32x16& x, int s) {
  u32x4 p; p.x = cvt_pk_bf16(x[8 * s], x[8 * s + 1]); p.y = cvt_pk_bf16(x[8 * s + 2], x[8 * s + 3]); p.z = cvt_pk_bf16(x[8 * s + 4], x[8 * s + 5]); p.w = cvt_pk_bf16(x[8 * s + 6], x[8 * s + 7]);
  return __builtin_bit_cast(bf16x8, p);
}
#define GMFMA(a, b, c) __builtin_amdgcn_mfma_f32_32x32x16_bf16((a), (b), (c), 0, 0, 0)

__device__ __forceinline__ void chain(const Params& P, LAS char* lds, int chain_id, const int tid) {
  const bool samp = chain_id < 64; const int cc = samp ? chain_id : chain_id - 64;
  const int b = cc >> 3, h = (cc >> 1) & 3, dir = cc & 1;
#ifdef DBG_GLA_CHECK
  const int L = samp ? SEQ_S : SEQ_P, nchunk = (chain_id == 64) ? 1 : L / 64, tok0 = samp ? NP + b * SEQ_S : b * SEQ_P;
#else
  const int L = samp ? SEQ_S : SEQ_P, nchunk = L / 64, tok0 = samp ? NP + b * SEQ_S : b * SEQ_P;
#endif
  const int w = tid >> 6, lane = tid & 63, r32 = lane & 31, hi = lane >> 5;
  const int dk = tid & 127, tg = tid >> 7, dv = tid & 255, th = tid >> 8;
  const bf16_t* QA = (const bf16_t*)(P.ws + WS_QA); const bf16_t* KA = (const bf16_t*)(P.ws + WS_KA); const bf16_t* VA = (const bf16_t*)(P.ws + WS_VA);
  const float* AFAB = (const float*)(P.ws + WS_AFAB);
  bf16_t* OUT = (bf16_t*)(P.ws + (dir ? WS_OB : WS_OF));
  const float* wal = dir ? P.in[I_WAB] : P.in[I_WAF]; const float* bal = dir ? P.in[I_BAB] : P.in[I_BAF];
  LAS float* wal_l = (LAS float*)(lds + G_WA);
  for (int i = tid; i < 17 * 128; i += NTHREADS) wal_l[i] = (i < 2048) ? wal[(i >> 7) * 512 + h * 128 + (i & 127)] : bal[h * 128 + (i & 127)];
  f32x16 St[4];
  if (samp) { const float* s0 = (dir ? P.in[I_SB] : P.in[I_SF]) + (size_t)(b * 4 + h) * 128 * 256;
#pragma unroll
    for (int kb = 0; kb < 4; ++kb)
#pragma unroll
      for (int r = 0; r < 16; ++r) St[kb][r] = s0[(size_t)(32 * kb + crow(r, hi)) * 256 + 32 * w + r32];
  } else {
#pragma unroll
    for (int kb = 0; kb < 4; ++kb)
#pragma unroll
      for (int r = 0; r < 16; ++r) St[kb][r] = 0.f;
  }
  LAS float* afl = (LAS float*)(lds + G_AF); LAS float* tot = (LAS float*)(lds + G_TOT); LAS float* ebl = (LAS float*)(lds + G_EBL);
  for (int ch = 0; ch < nchunk; ++ch) {
#define TOK(i) (tok0 + (dir ? (L - 1 - (64 * ch + (i))) : (64 * ch + (i))))
    if (tid < 256) { const int i = tid >> 2, q = tid & 3; *((LAS f32x4*)afl + tid) = *(const f32x4*)(AFAB + (size_t)TOK(i) * 32 + dir * 16 + 4 * q); }
#pragma unroll
    for (int n = 0; n < 2; ++n) { const int c = tid + 512 * n, i = c >> 4, d0 = (c & 15) * 8; const size_t t = (size_t)TOK(i);
      const u32x4 xq = *(const u32x4*)(QA + t * 512 + h * 128 + d0), xk = *(const u32x4*)(KA + t * 512 + h * 128 + d0);
      const int p0 = swz23(d0 & 15) | (d0 & ~15), p1 = swz23((d0 + 4) & 15) | (d0 & ~15);
      *(LAS u32x2*)(lds + G_QE + qe_addr(i, p0)) = (u32x2){xq.x, xq.y}; *(LAS u32x2*)(lds + G_QE + qe_addr(i, p1)) = (u32x2){xq.z, xq.w};
      *(LAS u32x2*)(lds + G_KE + qe_addr(i, p0)) = (u32x2){xk.x, xk.y}; *(LAS u32x2*)(lds + G_KE + qe_addr(i, p1)) = (u32x2){xk.z, xk.w}; }
#pragma unroll
    for (int n = 0; n < 4; ++n) { const int c = tid + 512 * n, i = c >> 5, cq = c & 31;
      *(LAS u32x4*)(lds + G_VR + i * 528 + cq * 16) = *(const u32x4*)(VA + (size_t)TOK(i) * 1024 + h * 256 + cq * 8); }
    __syncthreads();
    float bl[16]; float run = 0.f;
    float wa[16];
#pragma unroll
    for (int r = 0; r < 16; ++r) wa[r] = wal_l[r * 128 + dk];
    const float ba = wal_l[2048 + dk];
#pragma unroll
    for (int ii = 0; ii < 16; ++ii) { const int i = 16 * tg + ii; float z = ba;
#pragma unroll
      for (int q = 0; q < 4; ++q) { const f32x4 a = *((const LAS f32x4*)afl + i * 4 + q); z += a.x * wa[4 * q] + a.y * wa[4 * q + 1] + a.z * wa[4 * q + 2] + a.w * wa[4 * q + 3]; }
      const float g = (fminf(z, 0.f) - log1pf(expf(-fabsf(z)))) * (1.0f / 16.0f);
      run += g; bl[ii] = run; }
    tot[tg * 128 + dk] = run;
#pragma unroll
    for (int q = 0; q < 4; ++q) { const int b16 = (q >> 1) * 16, q8 = (q & 1) * 8; unsigned short e[8];
#pragma unroll
      for (int j = 0; j < 8; ++j) e[j] = *(const LAS unsigned short*)(lds + G_VR + (32 * th + b16 + swz23(q8 + j)) * 528 + dv * 2);
      u32x4 o; o.x = (unsigned)e[0] | ((unsigned)e[1] << 16); o.y = (unsigned)e[2] | ((unsigned)e[3] << 16); o.z = (unsigned)e[4] | ((unsigned)e[5] << 16); o.w = (unsigned)e[6] | ((unsigned)e[7] << 16);
      *(LAS u32x4*)(lds + G_VT + t_addr(dv, 4 * th + q)) = o; }
    __syncthreads();
    const float t0 = tot[dk], t1 = tot[128 + dk], t2 = tot[256 + dk], t3 = tot[384 + dk];
    const float pre = (tg > 0 ? t0 : 0.f) + (tg > 1 ? t1 : 0.f) + (tg > 2 ? t2 : 0.f), total = (t0 + t1) + (t2 + t3);
    if (tg == 0) ebl[dk] = expf(total);
    const int pdk = swz23(dk & 15) | (dk & ~15);
    unsigned short kdv[16];
#pragma unroll
    for (int ii = 0; ii < 16; ++ii) { const int i = 16 * tg + ii; const float bc = pre + bl[ii];
      LAS unsigned short* qp = (LAS unsigned short*)(lds + G_QE + qe_addr(i, pdk)); LAS unsigned short* kp = (LAS unsigned short*)(lds + G_KE + qe_addr(i, pdk));
      const float q = bf2f(*qp), k = bf2f(*kp);
      const unsigned pq = cvt_pk_bf16(q * expf(bc), k * expf(-bc));
      *qp = (unsigned short)(pq & 0xffffu); *kp = (unsigned short)(pq >> 16);
      kdv[ii] = (unsigned short)(cvt_pk_bf16(k * expf(total - bc), 0.f) & 0xffffu); }
#pragma unroll
    for (int q = 0; q < 2; ++q) { u32x4 o;
      o.x = (unsigned)kdv[swz23(8 * q + 0)] | ((unsigned)kdv[swz23(8 * q + 1)] << 16); o.y = (unsigned)kdv[swz23(8 * q + 2)] | ((unsigned)kdv[swz23(8 * q + 3)] << 16);
      o.z = (unsigned)kdv[swz23(8 * q + 4)] | ((unsigned)kdv[swz23(8 * q + 5)] << 16); o.w = (unsigned)kdv[swz23(8 * q + 6)] | ((unsigned)kdv[swz23(8 * q + 7)] << 16);
      *(LAS u32x4*)(lds + G_KDT + t_addr(dk, 2 * tg + q)) = o; }
    __syncthreads();
    bf16x8 Sb[4][2];
#pragma unroll
    for (int kb = 0; kb < 4; ++kb) { Sb[kb][0] = pack8(St[kb], 0); Sb[kb][1] = pack8(St[kb], 1); }
    f32x16 o[2];
#pragma unroll
    for (int ib = 0; ib < 2; ++ib) {
#pragma unroll
      for (int r = 0; r < 16; ++r) o[ib][r] = 0.f;
#pragma unroll
      for (int kb = 0; kb < 4; ++kb)
#pragma unroll
        for (int s = 0; s < 2; ++s) { const bf16x8 a = *(const LAS bf16x8*)(lds + G_QE + qe_addr(32 * ib + r32, 32 * kb + 16 * s + 8 * hi)); o[ib] = GMFMA(a, Sb[kb][s], o[ib]); }
      asm volatile("" ::: "memory");
    }
    bf16x8 vf[2][2];
#pragma unroll
    for (int jb = 0; jb < 2; ++jb)
#pragma unroll
      for (int s = 0; s < 2; ++s) vf[jb][s] = *(const LAS bf16x8*)(lds + G_VT + t_addr(32 * w + r32, 4 * jb + 2 * s + hi));
#pragma unroll
    for (int blk = 0; blk < 3; ++blk) { const int jb = (blk == 2) ? 1 : 0, ib = (blk == 0) ? 0 : 1;
      f32x16 X;
#pragma unroll
      for (int r = 0; r < 16; ++r) X[r] = 0.f;
#pragma unroll
      for (int ks = 0; ks < 8; ++ks) { const bf16x8 a = *(const LAS bf16x8*)(lds + G_KE + qe_addr(32 * jb + r32, 16 * ks + 8 * hi));
        const bf16x8 bq = *(const LAS bf16x8*)(lds + G_QE + qe_addr(32 * ib + r32, 16 * ks + 8 * hi)); X = GMFMA(a, bq, X); }
      if (jb == ib) {
#pragma unroll
        for (int r = 0; r < 16; ++r) X[r] = (r32 >= crow(r, hi)) ? X[r] : 0.f; }
#pragma unroll
      for (int s = 0; s < 2; ++s) { const bf16x8 xa = pack8(X, s); o[ib] = GMFMA(xa, vf[jb][s], o[ib]); }
      asm volatile("" ::: "memory");
    }
#pragma unroll
    for (int kb = 0; kb < 4; ++kb) {
#pragma unroll
      for (int g = 0; g < 4; ++g) { const f32x4 e4 = *(const LAS f32x4*)(ebl + 32 * kb + 8 * g + 4 * hi);
        St[kb][4 * g] *= e4.x; St[kb][4 * g + 1] *= e4.y; St[kb][4 * g + 2] *= e4.z; St[kb][4 * g + 3] *= e4.w; }
#pragma unroll
      for (int jb = 0; jb < 2; ++jb)
#pragma unroll
        for (int s = 0; s < 2; ++s) { const bf16x8 a = *(const LAS bf16x8*)(lds + G_KDT + t_addr(32 * kb + r32, 4 * jb + 2 * s + hi)); St[kb] = GMFMA(a, vf[jb][s], St[kb]); }
      asm volatile("" ::: "memory");
    }
#pragma unroll
    for (int ib = 0; ib < 2; ++ib)
#pragma unroll
      for (int r = 0; r < 16; ++r) OUT[(size_t)TOK(32 * ib + crow(r, hi)) * 1024 + h * 256 + 32 * w + r32] = (bf16_t)(cvt_pk_bf16(o[ib][r], 0.f) & 0xffffu);
    __syncthreads();
#undef TOK
  }
#ifdef DBG_GLA_CHECK
  if (chain_id == 64) { unsigned* dump = (unsigned*)(P.ws + WS_END); for (int i = tid; i < 96768 / 4; i += NTHREADS) dump[i] = *(const LAS unsigned*)(lds + 4 * i); __syncthreads(); }
#endif
  if (!samp) { float* so = P.out + (dir ? O_NB : O_NF) + (size_t)(b * 4 + h) * 128 * 256;
#pragma unroll
    for (int kb = 0; kb < 4; ++kb)
#pragma unroll
      for (int r = 0; r < 16; ++r) so[(size_t)(32 * kb + crow(r, hi)) * 256 + 32 * w + r32] = St[kb][r]; }
}
}

constexpr int Q_GLA = 192, Q_AS = 1024, Q_AP = 256, Q_ATT = Q_AS + Q_AP;
__device__ __forceinline__ void p3_mixers(Frame& F) {
    const Params& P = *F.p;
    unsigned* ctr = (unsigned*)(P.ws + WS_CTL);
    LAS unsigned* slot = (LAS unsigned*)(F.lds + LDS_BYTES - 64);
    for (;;) {
        if (F.tid == 0) *slot = atomicAdd(ctr, 1u);
        __syncthreads();
        const int u = (int)*slot;
        __syncthreads();
        if (u >= Q_GLA) break;
        gla::chain(P, (LAS char*)F.lds, u, F.tid);
    }
    const float lam = ((const float*)(P.ws + WS_MOD))[9 * 6144];
    const bf16_t* QD = (const bf16_t*)(P.ws + WS_QD); const bf16_t* KD = (const bf16_t*)(P.ws + WS_KD); const bf16_t* VD = (const bf16_t*)(P.ws + WS_VD);
    const bf16_t* CK = (const bf16_t*)(P.ws + WS_CK); const bf16_t* CV = (const bf16_t*)(P.ws + WS_CV); bf16_t* ODN = (bf16_t*)(P.ws + WS_ODN);
    for (;;) {
        if (F.tid == 0) *slot = atomicAdd(ctr + 64, 1u);
        __syncthreads();
        const int u = (int)*slot;
        __syncthreads();
        if (u >= Q_ATT) break;
        att::Unit U;
        if (u < Q_AS) {
            const int b = u >> 7, h = (u >> 4) & 7, qb = u & 15; const size_t tok0 = NP + (size_t)b * SEQ_S;
            U.Q = QD + (tok0 + qb * 128) * 1024 + h * 128; U.K0 = KD + tok0 * 1024 + h * 128; U.V0 = VD + tok0 * 1024 + h * 128;
            U.K1 = CK + (size_t)b * PAST * 1024 + h * 128; U.V1 = CV + (size_t)b * PAST * 1024 + h * 128; U.O = ODN + (tok0 + qb * 128) * 1024 + h * 128; U.nt0 = 32; U.NT = 36;
        } else {
            const int a = u - Q_AS, b = a >> 4, h = (a >> 1) & 7, qb = a & 1; const size_t tok0 = (size_t)b * SEQ_P;
            U.Q = QD + (tok0 + qb * 128) * 1024 + h * 128; U.K0 = KD + tok0 * 1024 + h * 128; U.V0 = VD + tok0 * 1024 + h * 128;
            U.K1 = U.K0; U.V1 = U.V0; U.O = ODN + (tok0 + qb * 128) * 1024 + h * 128; U.nt0 = 4; U.NT = 4;
        }
        att::unit_body(U, (LAS char*)F.lds, lam, P.in[I_SUBG], F.tid);
    }
}

__device__ __forceinline__ void p4_glanorm(Frame& F) {
    const Params& P = *F.p;
    const bf16_t* OFp = (const bf16_t*)(P.ws + WS_OF); const bf16_t* OBp = (const bf16_t*)(P.ws + WS_OB); const bf16_t* RA = (const bf16_t*)(P.ws + WS_RA);
    bf16_t* OAN = (bf16_t*)(P.ws + WS_OAN);
    const f32x4 g = *((const f32x4*)P.in[I_GLAG] + F.lane);
    const int gw = F.vcu * NWAVES + F.wave, NGW = F.G * NWAVES;
    for (int m = gw; m < NTOK; m += NGW) {
        const size_t rb = (size_t)m * 1024 + 4 * F.lane;
#pragma unroll
        for (int j = 0; j < 4; ++j) {
            const u32x2 a = *(const u32x2*)(OFp + rb + 256 * j), b = *(const u32x2*)(OBp + rb + 256 * j), r = *(const u32x2*)(RA + rb + 256 * j);
            f32x4 f; f.x = bflo(a.x) + bflo(b.x); f.y = bfhi(a.x) + bfhi(b.x); f.z = bflo(a.y) + bflo(b.y); f.w = bfhi(a.y) + bfhi(b.y);
            const float ss = wave_sum((f.x * f.x + f.y * f.y) + (f.z * f.z + f.w * f.w));
            const float rs = 1.f / sqrtf(ss * (1.f / 256.f) + LN_EPS);
            u32x2 o; o.x = cvt_pk_bf16(f.x * rs * g.x * bflo(r.x), f.y * rs * g.y * bfhi(r.x)); o.y = cvt_pk_bf16(f.z * rs * g.z * bflo(r.y), f.w * rs * g.w * bfhi(r.y));
            *(u32x2*)(OAN + rb + 256 * j) = o;
        }
    }
}

struct SchedMrg {
    struct U { int pm, pn, sub; };
    const char* A0; long dA; const char* B0; long dB; int lda, ldb, nt, G, c;
    __device__ __forceinline__ bool next(int i, U& u) const { const int tl = c + G * (i >> 1); if (tl >= 320) return false; u.pm = tl >> 2; u.pn = tl & 3; u.sub = i & 1; return true; }
    __device__ __forceinline__ const char* a_base(const U& u) const { return A0 + (long)u.sub * dA; }
    __device__ __forceinline__ unsigned a_row(const U& u, int r) const { return (unsigned)(u.pm * 256 + r); }
    __device__ __forceinline__ const char* b_base(const U& u) const { return B0 + (long)u.sub * dB + (size_t)u.pn * 256 * ldb * 2; }
};
struct EpiMrg {
    const bf16_t* GA; const bf16_t* GB; bf16_t* M;
    __device__ __forceinline__ void operator()(const f32x4 (&acc)[2][2][4][2], const SchedMrg::U& u, int wr, int wc, int fr, int fq) const {
        const int row0 = u.pm * 256 + wr * 64 + fr, col0 = u.pn * 256 + wc * 32 + 8 * fq;
        const bf16_t* G = GA + (long)u.sub * (GB - GA);
#pragma unroll
        for (int ai = 0; ai < 2; ++ai)
#pragma unroll
            for (int m = 0; m < 4; ++m)
#pragma unroll
                for (int bj = 0; bj < 2; ++bj) {
                    const size_t off = (size_t)(row0 + ai * 128 + m * 16) * 1024 + col0 + bj * 128;
                    const u32x4 g = *(const u32x4*)(G + off);
                    f32x4 t0 = acc[ai][bj][m][0], t1 = acc[ai][bj][m][1];
                    t0 = t0 * (f32x4){bflo(g.x), bfhi(g.x), bflo(g.y), bfhi(g.y)}; t1 = t1 * (f32x4){bflo(g.z), bfhi(g.z), bflo(g.w), bfhi(g.w)};
                    if (u.sub) { const u32x4 p = *(const u32x4*)(M + off);
                        t0 = t0 + (f32x4){bflo(p.x), bfhi(p.x), bflo(p.y), bfhi(p.y)}; t1 = t1 + (f32x4){bflo(p.z), bfhi(p.z), bflo(p.w), bfhi(p.w)}; }
                    u32x4 w; w.x = cvt_pk_bf16(t0.x, t0.y); w.y = cvt_pk_bf16(t0.z, t0.w); w.z = cvt_pk_bf16(t1.x, t1.y); w.w = cvt_pk_bf16(t1.z, t1.w);
                    *(u32x4*)(M + off) = w;
                    asm volatile("" ::: "memory");
                }
    }
};

struct SchedOut {
    struct U { int pm, pn; };
    const char* A; const char* B; int lda, ldb, nt, G, c;
    __device__ __forceinline__ bool next(int i, U& u) const { const int tl = c + G * i; if (tl >= 320) return false; u.pm = tl >> 2; u.pn = tl & 3; return true; }
    __device__ __forceinline__ const char* a_base(const U&) const { return A; }
    __device__ __forceinline__ unsigned a_row(const U& u, int r) const { return (unsigned)(u.pm * 256 + r); }
    __device__ __forceinline__ const char* b_base(const U& u) const { return B + (size_t)u.pn * 256 * ldb * 2; }
};
constexpr float ALPHA = 1.189207115002721f;
struct EpiOut {
    const Params* P; const float* mod; float* V1;
    __device__ __forceinline__ void operator()(const f32x4 (&acc)[2][2][4][2], const SchedOut::U& u, int wr, int wc, int fr, int fq) const {
        const int row0 = u.pm * 256 + wr * 64 + fr, col0 = u.pn * 256 + wc * 32 + 8 * fq;
        const float* g1 = mod + mod_row(u.pm * 256) * 6144 + 2048;
#pragma unroll
        for (int ai = 0; ai < 2; ++ai)
#pragma unroll
            for (int m = 0; m < 4; ++m) { const int row = row0 + ai * 128 + m * 16; const float* xr = xrow_ptr(*P, row);
#pragma unroll
                for (int bj = 0; bj < 2; ++bj) { const int col = col0 + bj * 128;
#pragma unroll
                    for (int n = 0; n < 2; ++n) { const f32x4 x = *(const f32x4*)(xr + col + 4 * n), g = *(const f32x4*)(g1 + col + 4 * n);
                        *(f32x4*)(V1 + (size_t)row * 1024 + col + 4 * n) = x * ALPHA + g * acc[ai][bj][m][n]; } } }
    }
};

__device__ __forceinline__ void p7_ln1_router(Frame& F) {
    const Params& P = *F.p;
    LAS float* wrT = (LAS float*)F.lds;
    const float* wr = P.in[I_WR];
    for (int i = F.tid; i < 1024 * 16; i += NTHREADS) { const int k = i >> 4, e = i & 15; wrT[e * 1024 + k] = wr[i]; }
    __syncthreads();
    const float* mod = (const float*)(P.ws + WS_MOD);
    float* X1 = P.out; bf16_t* H2 = (bf16_t*)(P.ws + WS_H2); float* aff = (float*)(P.ws + WS_AFF); int* sel = (int*)(P.ws + WS_SEL);
    const int gw = F.vcu * NWAVES + F.wave, NGW = F.G * NWAVES, lane = F.lane;
    for (int m = gw; m < NTOK; m += NGW) {
        f32x4* xr = (f32x4*)(X1 + (size_t)m * D) + lane;
        f32x4 v[4]; float s = 0.f;
#pragma unroll
        for (int j = 0; j < 4; ++j) { v[j] = xr[64 * j]; s += (v[j].x + v[j].y) + (v[j].z + v[j].w); }
        float mean = wave_sum(s) * (1.f / D), s2 = 0.f;
#pragma unroll
        for (int j = 0; j < 4; ++j) { v[j] = v[j] - mean; s2 += (v[j].x * v[j].x + v[j].y * v[j].y) + (v[j].z * v[j].z + v[j].w * v[j].w); }
        float rstd = 1.f / sqrtf(wave_sum(s2) * (1.f / D) + LN_EPS);
        s = 0.f;
#pragma unroll
        for (int j = 0; j < 4; ++j) { const f32x4 g = *((const f32x4*)P.in[I_LN1G] + lane + 64 * j), b = *((const f32x4*)P.in[I_LN1B] + lane + 64 * j);
            v[j] = v[j] * rstd * g + b; xr[64 * j] = v[j]; s += (v[j].x + v[j].y) + (v[j].z + v[j].w); }
        mean = wave_sum(s) * (1.f / D); s2 = 0.f;
#pragma unroll
        for (int j = 0; j < 4; ++j) { v[j] = v[j] - mean; s2 += (v[j].x * v[j].x + v[j].y * v[j].y) + (v[j].z * v[j].z + v[j].w * v[j].w); }
        rstd = 1.f / sqrtf(wave_sum(s2) * (1.f / D) + LN_EPS);
        const float* md = mod + mod_row(m) * 6144;
        u32x2* o8 = (u32x2*)(H2 + (size_t)m * D) + lane;
#pragma unroll
        for (int j = 0; j < 4; ++j) { const f32x4 sh = *((const f32x4*)(md + 3072) + lane + 64 * j), sc = *((const f32x4*)(md + 4096) + lane + 64 * j);
            v[j] = v[j] * rstd * (sc + 1.0f) + sh;
            u32x2 w; w.x = cvt_pk_bf16(v[j].x, v[j].y); w.y = cvt_pk_bf16(v[j].z, v[j].w); o8[64 * j] = w; }
        float vals[16];
#pragma unroll
        for (int e = 0; e < 16; ++e) { float a = 0.f;
#pragma unroll
            for (int j = 0; j < 4; ++j) { const f32x4 w = *((const LAS f32x4*)wrT + e * 256 + lane + 64 * j); a += (v[j].x * w.x + v[j].y * w.y) + (v[j].z * w.z + v[j].w * w.w); }
            vals[e] = a; asm volatile("" ::: "memory"); }
        TR_STEP(32, 8) TR_STEP(16, 4) TR_STEP(8, 2) TR_STEP(4, 1)
        float lg = vals[0]; lg += __shfl_xor(lg, 1); lg += __shfl_xor(lg, 2);
        float mx = lg;
#pragma unroll
        for (int o = 4; o < 64; o <<= 1) mx = fmaxf(mx, __shfl_xor(mx, o));
        const float ex = expf(lg - mx); float sm = ex;
#pragma unroll
        for (int o = 4; o < 64; o <<= 1) sm += __shfl_xor(sm, o);
        if ((lane & 3) == 0) { aff[(size_t)m * 16 + (lane >> 2)] = ex / sm; sel[(size_t)m * 16 + (lane >> 2)] = -1; }
    }
    __syncthreads();
}

__device__ __forceinline__ void p8_topk(Frame& F) {
    const Params& P = *F.p;
    if (F.vcu < 32) {
        const int g = F.vcu >> 4, e = F.vcu & 15;
        const int n = g ? NS : NP, cap = n / 8, base = g ? NP : 0, sbase = e * SLOTS_E + (g ? CAP_P : 0);
        LAS unsigned* keys = (LAS unsigned*)F.lds;
        LAS unsigned* hist = keys + 16384;
        LAS unsigned* misc = hist + 256;
        const float* aff = (const float*)(P.ws + WS_AFF);
        for (int i = F.tid; i < n; i += NTHREADS) keys[i] = __float_as_uint(aff[(size_t)(base + i) * 16 + e]);
        unsigned prefix = 0u, mask = 0u, need = (unsigned)cap;
        for (int pass = 0; pass < 4; ++pass) {
            const int shift = 24 - 8 * pass;
            if (F.tid < 256) hist[F.tid] = 0u;
            __syncthreads();
            for (int i = F.tid; i < n; i += NTHREADS) { const unsigned k = keys[i]; if ((k & mask) == prefix) atomicAdd((unsigned*)&hist[(k >> shift) & 255u], 1u); }
            __syncthreads();
            if (F.tid < 256) { unsigned sfx = 0u; for (int b = 255; b > F.tid; --b) sfx += hist[b];
                const unsigned mine = hist[F.tid];
                if (sfx < need && sfx + mine >= need) { misc[0] = (unsigned)F.tid; misc[1] = need - sfx; } }
            __syncthreads();
            prefix |= misc[0] << shift; mask |= 255u << shift; need = misc[1];
            __syncthreads();
        }
        const unsigned T = prefix;
        int* list = (int*)(P.ws + WS_LIST); float* gate = (float*)(P.ws + WS_GATE); int* sel = (int*)(P.ws + WS_SEL);
        unsigned run_gt = 0u, run_eq = 0u;
        const unsigned long long lt = (1ull << F.lane) - 1ull;
        for (int it = 0; it < n / NTHREADS; ++it) {
            const int i = it * NTHREADS + F.tid; const unsigned k = keys[i];
            const bool gt = k > T, eq = k == T;
            const unsigned long long bg = __ballot(gt), be = __ballot(eq);
            if (F.lane == 0) { misc[8 + F.wave] = (unsigned)__popcll(bg); misc[16 + F.wave] = (unsigned)__popcll(be); }
            __syncthreads();
            unsigned pg = run_gt, pe = run_eq, tg = 0u, te = 0u;
#pragma unroll
            for (int w = 0; w < NWAVES; ++w) { const unsigned cg_ = misc[8 + w], ce_ = misc[16 + w]; if (w < F.wave) { pg += cg_; pe += ce_; } tg += cg_; te += ce_; }
            pg += (unsigned)__popcll(bg & lt); pe += (unsigned)__popcll(be & lt);
            if (gt || (eq && pe < need)) { const int slot = sbase + (int)(pg + (pe < need ? pe : need));
                list[slot] = base + i; gate[slot] = __uint_as_float(k); sel[(size_t)(base + i) * 16 + e] = slot; }
            run_gt += tg; run_eq += te;
            __syncthreads();
        }
    } else {
        LAS float* scr = (LAS float*)F.lds + F.wave * (64 * 33);
        const int gw = (F.vcu - 32) * NWAVES + F.wave, NGW = (F.G - 32) * NWAVES;
        for (int it = gw; it < 16 * 44 * 32; it += NGW) { const int e = it / (44 * 32), q = it % (44 * 32), kb = q >> 5, nb = q & 31;
            transpose_item(P.in[I_WED] + (size_t)e * FF * 1024, 1024, (bf16_t*)(P.ws + WS_WD), FF, 64 * kb, 32 * nb, (size_t)e * 1024 + 32 * nb, scr, F.lane); }
    }
}

struct SchedMoe1 {
    struct U { int e, mt, nt_; };
    const char* A; const char* B; const int* list; int lda, ldb, nt, G, c;
    __device__ __forceinline__ bool next(int i, U& u) const { const int L = i * G + c; if (L >= 3520) return false; u.e = L / 220; const int r = L % 220; u.mt = r % 10; u.nt_ = r / 10; return true; }
    __device__ __forceinline__ const char* a_base(const U&) const { return A; }
    __device__ __forceinline__ unsigned a_row(const U& u, int r) const { return (unsigned)list[u.e * SLOTS_E + u.mt * 256 + r]; }
    __device__ __forceinline__ const char* b_base(const U& u) const { return B + ((size_t)u.e * 5632 + (size_t)u.nt_ * 256) * ldb * 2; }
};
struct EpiMoe1 {
    bf16_t* HID;
    __device__ __forceinline__ void operator()(const f32x4 (&acc)[2][2][4][2], const SchedMoe1::U& u, int wr, int wc, int fr, int fq) const {
        const int row0 = u.e * SLOTS_E + u.mt * 256 + wr * 64 + fr, col0 = u.nt_ * 128 + wc * 32 + 8 * fq;
#pragma unroll
        for (int ai = 0; ai < 2; ++ai)
#pragma unroll
            for (int m = 0; m < 4; ++m) {
                float t[8];
#pragma unroll
                for (int n = 0; n < 2; ++n)
#pragma unroll
                    for (int j = 0; j < 4; ++j) t[4 * n + j] = siluf_(acc[ai][0][m][n][j]) * acc[ai][1][m][n][j];
                u32x4 w; w.x = cvt_pk_bf16(t[0], t[1]); w.y = cvt_pk_bf16(t[2], t[3]); w.z = cvt_pk_bf16(t[4], t[5]); w.w = cvt_pk_bf16(t[6], t[7]);
                *(u32x4*)(HID + (size_t)(row0 + ai * 128 + m * 16) * FF + col0) = w;
            }
    }
};

struct SchedMoe2 {
    struct U { int e, mt, n2, ks; };
    const char* A; const char* B; int lda, ldb, nt, G, c;
    __device__ __forceinline__ bool next(int i, U& u) const { const int L = i * G + c; if (L >= 1280) return false; u.ks = L & 1; u.n2 = (L >> 1) & 3; const int mg = L >> 3; u.e = mg / 10; u.mt = mg % 10; return true; }
    __device__ __forceinline__ const char* a_base(const U& u) const { return A + (size_t)u.ks * 1408 * 2; }
    __device__ __forceinline__ unsigned a_row(const U& u, int r) const { return (unsigned)(u.e * SLOTS_E + u.mt * 256 + r); }
    __device__ __forceinline__ const char* b_base(const U& u) const { return B + (((size_t)u.e * 1024 + (size_t)u.n2 * 256) * ldb + (size_t)u.ks * 1408) * 2; }
};
struct EpiMoe2 {
    bf16_t* YE; const float* gate;
    __device__ __forceinline__ void operator()(const f32x4 (&acc)[2][2][4][2], const SchedMoe2::U& u, int wr, int wc, int fr, int fq) const {
        const int row0 = u.e * SLOTS_E + u.mt * 256 + wr * 64 + fr, col0 = u.n2 * 256 + wc * 32 + 8 * fq;
        bf16_t* Y = YE + (size_t)u.ks * NSLOT * 1024;
#pragma unroll
        for (int ai = 0; ai < 2; ++ai)
#pragma unroll
            for (int m = 0; m < 4; ++m) { const int row = row0 + ai * 128 + m * 16; const float gt = gate[row];
#pragma unroll
                for (int bj = 0; bj < 2; ++bj) { const f32x4 v0 = acc[ai][bj][m][0] * gt, v1 = acc[ai][bj][m][1] * gt;
                    u32x4 w; w.x = cvt_pk_bf16(v0.x, v0.y); w.y = cvt_pk_bf16(v0.z, v0.w); w.z = cvt_pk_bf16(v1.x, v1.y); w.w = cvt_pk_bf16(v1.z, v1.w);
                    *(u32x4*)(Y + (size_t)row * 1024 + col0 + bj * 128) = w; } }
    }
};

__device__ __forceinline__ void p11_final(Frame& F) {
    const Params& P = *F.p;
    const float* mod = (const float*)(P.ws + WS_MOD); const int* sel = (const int*)(P.ws + WS_SEL); const bf16_t* YE = (const bf16_t*)(P.ws + WS_YE);
    const int gw = F.vcu * NWAVES + F.wave, NGW = F.G * NWAVES, lane = F.lane;
    for (int m = gw; m < NTOK; m += NGW) {
        f32x4* xr = (f32x4*)(P.out + (size_t)m * D) + lane;
        f32x4 v[4], mo[4];
#pragma unroll
        for (int j = 0; j < 4; ++j) { v[j] = xr[64 * j]; mo[j] = (f32x4){0.f, 0.f, 0.f, 0.f}; }
        const int myslot = sel[(size_t)m * 16 + (lane & 15)];
        for (int e = 0; e < 16; ++e) { const int sl = __builtin_amdgcn_readlane(myslot, e);
            if (sl >= 0) {
#pragma unroll
                for (int ks = 0; ks < 2; ++ks) { const bf16_t* yr = YE + ((size_t)ks * NSLOT + sl) * 1024 + 4 * lane;
#pragma unroll
                    for (int j = 0; j < 4; ++j) { const u32x2 a = *(const u32x2*)(yr + 256 * j); mo[j].x += bflo(a.x); mo[j].y += bfhi(a.x); mo[j].z += bflo(a.y); mo[j].w += bfhi(a.y); } } } }
        const float* g2 = mod + mod_row(m) * 6144 + 5120; float s = 0.f;
#pragma unroll
        for (int j = 0; j < 4; ++j) { const f32x4 g = *((const f32x4*)g2 + lane + 64 * j); v[j] = v[j] * ALPHA + g * mo[j]; s += (v[j].x + v[j].y) + (v[j].z + v[j].w); }
        const float mean = wave_sum(s) * (1.f / D); float s2 = 0.f;
#pragma unroll
        for (int j = 0; j < 4; ++j) { v[j] = v[j] - mean; s2 += (v[j].x * v[j].x + v[j].y * v[j].y) + (v[j].z * v[j].z + v[j].w * v[j].w); }
        const float rstd = 1.f / sqrtf(wave_sum(s2) * (1.f / D) + LN_EPS);
#pragma unroll
        for (int j = 0; j < 4; ++j) { const f32x4 g = *((const f32x4*)P.in[I_LN2G] + lane + 64 * j), b = *((const f32x4*)P.in[I_LN2B] + lane + 64 * j); xr[64 * j] = v[j] * rstd * g + b; }
    }
}

__global__ void __launch_bounds__(NTHREADS, 2) mega_fwd(Params P) {
    extern __shared__ __attribute__((aligned(16))) unsigned char lds_raw[];
    cg::grid_group grid = cg::this_grid();
    Frame F;
    F.lds = (LAS unsigned char*)lds_raw; F.tid = threadIdx.x; F.lane = F.tid & 63; F.wave = __builtin_amdgcn_readfirstlane(F.tid >> 6);
    F.G = gridDim.x; { const int bx = blockIdx.x; F.vcu = (F.G % 8 == 0) ? (bx % 8) * (F.G / 8) + bx / 8 : bx; }
    F.p = &P;
#define GRID_SYNC() do { grid.sync(); int t_ = threadIdx.x; asm volatile("" : "+v"(t_)); F.tid = t_; F.lane = t_ & 63; F.wave = __builtin_amdgcn_readfirstlane(t_ >> 6); \
        int v_ = F.vcu; asm volatile("" : "+s"(v_)); F.vcu = v_; } while (0)

    p0_prologue(F);
    GRID_SYNC();
    p1_ln0(F);
    GRID_SYNC();
    {
        SchedIn S{(const char*)P.out, (const char*)(P.ws + WS_WIN), 1024, 1024, 16, F.G, (int)blockIdx.x};
        EpiIn E{P.ws, P.out, (const float*)(P.ws + WS_ROPE)};
        pg8::gemm_phase(F.lds, S, E, F.tid);
    }
    GRID_SYNC();
    p3_mixers(F);
#ifdef DBG_GLA_CHECK
    GRID_SYNC();
    if (blockIdx.x == 0) {
        using namespace gla;
        const unsigned char* dl = P.ws + WS_END; const float* sd = P.out + O_NF;
        unsigned* dbg = (unsigned*)(P.ws + WS_CTL) + 128;
        const int tid = F.tid, dk = tid & 127, tg = tid >> 7, dv = tid & 255, th = tid >> 8, h = 0, dir = 0;
        const bf16_t* QA = (const bf16_t*)(P.ws + WS_QA); const bf16_t* KA = (const bf16_t*)(P.ws + WS_KA); const bf16_t* VA = (const bf16_t*)(P.ws + WS_VA);
        const float* AFAB = (const float*)(P.ws + WS_AFAB); const float* wal = P.in[I_WAF]; const float* bal = P.in[I_BAF];
        float d0 = 0.f, d1 = 0.f, d2 = 0.f, d3 = 0.f, d4 = 0.f, d5 = 0.f, bcum = 0.f, btot = 0.f;
        for (int i = 0; i < 64; ++i) { float z = bal[h * 128 + dk]; for (int r = 0; r < 16; ++r) z += AFAB[(size_t)i * 32 + dir * 16 + r] * wal[r * 512 + h * 128 + dk];
            btot += (fminf(z, 0.f) - log1pf(expf(-fabsf(z)))) * (1.0f / 16.0f); }
        for (int i = 0; i < 64; ++i) { float z = bal[h * 128 + dk]; for (int r = 0; r < 16; ++r) z += AFAB[(size_t)i * 32 + dir * 16 + r] * wal[r * 512 + h * 128 + dk];
            bcum += (fminf(z, 0.f) - log1pf(expf(-fabsf(z)))) * (1.0f / 16.0f);
            if ((i >> 4) == tg) { const float q = bf2f(QA[(size_t)i * 512 + h * 128 + dk]), k = bf2f(KA[(size_t)i * 512 + h * 128 + dk]);
                const int pdk2 = swz23(dk & 15) | (dk & ~15);
                d0 = fmaxf(d0, fabsf(q * expf(bcum) - bf2f(*(const unsigned short*)(dl + G_QE + qe_addr(i, pdk2)))));
                d1 = fmaxf(d1, fabsf(k * expf(-bcum) - bf2f(*(const unsigned short*)(dl + G_KE + qe_addr(i, pdk2)))) / (fabsf(k * expf(-bcum)) + 0.01f));
                const int pos = (i & ~15) | swz23(i & 15);
                d2 = fmaxf(d2, fabsf(k * expf(btot - bcum) - bf2f(*(const unsigned short*)(dl + G_KDT + t_addr(dk, pos >> 3) + (pos & 7) * 2)))); } }
        if (tg == 0) d4 = fabsf(expf(btot) - *(const float*)(dl + G_EBL + 4 * dk));
        for (int ii = 0; ii < 32; ++ii) { const int i = 32 * th + ii, pos = (i & ~15) | swz23(i & 15);
            d3 = fmaxf(d3, fabsf(bf2f(VA[(size_t)i * 1024 + h * 256 + dv]) - bf2f(*(const unsigned short*)(dl + G_VT + t_addr(dv, pos >> 3) + (pos & 7) * 2)))); }
        for (int el = tid; el < 128 * 256; el += NTHREADS) { const int dkk = el >> 8, dvv = el & 255; float e = 0.f;
            for (int pos = 0; pos < 64; ++pos) e += bf2f(*(const unsigned short*)(dl + G_KDT + t_addr(dkk, pos >> 3) + (pos & 7) * 2)) * bf2f(*(const unsigned short*)(dl + G_VT + t_addr(dvv, pos >> 3) + (pos & 7) * 2));
            d5 = fmaxf(d5, fabsf(e - sd[el])); }
        atomicMax(dbg + 0, __float_as_uint(d0)); atomicMax(dbg + 1, __float_as_uint(d1)); atomicMax(dbg + 2, __float_as_uint(d2));
        atomicMax(dbg + 3, __float_as_uint(d3)); atomicMax(dbg + 4, __float_as_uint(d4)); atomicMax(dbg + 5, __float_as_uint(d5));
    }
#endif
#ifdef DBG_NAIVE_GLA
    GRID_SYNC();
    if (blockIdx.x < 128) {
        const int cc = blockIdx.x, b = cc >> 3, h = (cc >> 1) & 3, dir = cc & 1, dk = F.tid & 127, dvq = F.tid >> 7;
        const bf16_t* KA = (const bf16_t*)(P.ws + WS_KA); const bf16_t* VA = (const bf16_t*)(P.ws + WS_VA); const float* AFAB = (const float*)(P.ws + WS_AFAB);
        const float* wal = dir ? P.in[I_WAB] : P.in[I_WAF]; const float* bal = dir ? P.in[I_BAB] : P.in[I_BAF];
        float S[64];
#pragma unroll
        for (int j = 0; j < 64; ++j) S[j] = 0.f;
        for (int t = 0; t < 256; ++t) {
            const int tok = b * 256 + (dir ? 255 - t : t);
            float z = bal[h * 128 + dk];
            for (int r = 0; r < 16; ++r) z += AFAB[(size_t)tok * 32 + dir * 16 + r] * wal[r * 512 + h * 128 + dk];
            const float g = (fminf(z, 0.f) - log1pf(expf(-fabsf(z)))) * (1.0f / 16.0f), eg = expf(g);
            const float k = bf2f(KA[(size_t)tok * 512 + h * 128 + dk]);
#pragma unroll
            for (int j = 0; j < 64; ++j) S[j] = S[j] * eg + k * bf2f(VA[(size_t)tok * 1024 + h * 256 + dvq * 64 + j]);
        }
        float* so = P.out + (dir ? O_NB : O_NF) + (size_t)(b * 4 + h) * 128 * 256;
#pragma unroll
        for (int j = 0; j < 64; ++j) so[(size_t)dk * 256 + dvq * 64 + j] = S[j];
    }
#endif
    GRID_SYNC();
    p4_glanorm(F);
    GRID_SYNC();
    {
        SchedMrg S{(const char*)(P.ws + WS_OAN), (long)WS_ODN - (long)WS_OAN, (const char*)(P.ws + WS_WA), (long)WS_WB - (long)WS_WA, 1024, 1024, 16, F.G, F.vcu};
        EpiMrg E{(const bf16_t*)(P.ws + WS_GA), (const bf16_t*)(P.ws + WS_GB), (bf16_t*)(P.ws + WS_MRG)};
        pg8::gemm_phase(F.lds, S, E, F.tid);
    }
    GRID_SYNC();
    {
        SchedOut S{(const char*)(P.ws + WS_MRG), (const char*)(P.ws + WS_WO), 1024, 1024, 16, F.G, F.vcu};
        EpiOut E{&P, (const float*)(P.ws + WS_MOD), P.out};
        pg8::gemm_phase(F.lds, S, E, F.tid);
    }
    GRID_SYNC();
    p7_ln1_router(F);
    GRID_SYNC();
    p8_topk(F);
    GRID_SYNC();
    {
        SchedMoe1 S{(const char*)(P.ws + WS_H2), (const char*)(P.ws + WS_WGU), (const int*)(P.ws + WS_LIST), 1024, 1024, 16, F.G, F.vcu};
        EpiMoe1 E{(bf16_t*)(P.ws + WS_HID)};
        pg8::gemm_phase(F.lds, S, E, F.tid);
    }
    GRID_SYNC();
    {
        SchedMoe2 S{(const char*)(P.ws + WS_HID), (const char*)(P.ws + WS_WD), FF, FF, 22, F.G, F.vcu};
        EpiMoe2 E{(bf16_t*)(P.ws + WS_YE), (const float*)(P.ws + WS_GATE)};
        pg8::gemm_phase(F.lds, S, E, F.tid);
    }
    GRID_SYNC();
    p11_final(F);
#ifdef DBG_GLA_CHECK
    GRID_SYNC();
    {
        const unsigned* dbg = (const unsigned*)(P.ws + WS_CTL) + 128;
        float code = 0.f;
        if (__uint_as_float(dbg[5]) > 0.05f) code = 1e6f;
        if (__uint_as_float(dbg[4]) > 1e-4f) code = 1e5f;
        if (__uint_as_float(dbg[3]) > 1e-6f) code = 1e4f;
        if (__uint_as_float(dbg[2]) > 0.02f) code = 1e3f;
        if (__uint_as_float(dbg[1]) > 0.02f) code = 1e2f;
        if (__uint_as_float(dbg[0]) > 0.02f) code = 1e1f;
        for (size_t i = (size_t)blockIdx.x * NTHREADS + F.tid; i < O_YS; i += (size_t)F.G * NTHREADS) P.out[i] = code;
    }
#endif
#ifdef DBG_ZERO_MASK
    GRID_SYNC();
    {
        const size_t starts[7] = {O_YP, O_YS, O_NK, O_NV, O_NF, O_NB, O_END};
        for (int o = 0; o < 6; ++o) if ((DBG_ZERO_MASK >> o) & 1)
            for (size_t i = starts[o] + (size_t)blockIdx.x * NTHREADS + F.tid; i < starts[o + 1]; i += (size_t)F.G * NTHREADS) P.out[i] = 0.f;
    }
#endif
}

extern "C" void kernel_launch(void* const* d_in, const int* in_sizes, int n_in, void* d_out, int out_size, void* d_ws, size_t ws_size, hipStream_t stream) {
    static int grid = 0;
    if (grid == 0) {
        if (n_in != 32 || out_size != (int)O_END || ws_size < WS_END + (1u << 20)) { fprintf(stderr, "kernel_launch: unexpected shapes: n_in %d out %d ws %zu (need %zu)\n", n_in, out_size, ws_size, (size_t)WS_END); grid = -1; return; }
        int dev = 0, cus = 0, per_cu = 0;
        if (hipGetDevice(&dev) != hipSuccess || hipDeviceGetAttribute(&cus, hipDeviceAttributeMultiprocessorCount, dev) != hipSuccess) { grid = -1; return; }
        if (hipFuncSetAttribute((const void*)mega_fwd, hipFuncAttributeMaxDynamicSharedMemorySize, LDS_BYTES) != hipSuccess) { fprintf(stderr, "kernel_launch: hipFuncSetAttribute failed\n"); grid = -1; return; }
        if (hipOccupancyMaxActiveBlocksPerMultiprocessor(&per_cu, (const void*)mega_fwd, NTHREADS, LDS_BYTES) != hipSuccess || per_cu < 1) { fprintf(stderr, "kernel_launch: occupancy query says %d\n", per_cu); per_cu = 1; }
        (void)hipGetLastError();
        grid = cus;
    }
    if (grid < 0) return;
    (void)hipMemsetAsync((char*)d_ws + WS_CTL, 0, 65536, stream);
    Params p{};
    for (int i = 0; i < 32; ++i) p.in[i] = (const float*)d_in[i];
    p.out = (float*)d_out; p.ws = (unsigned char*)d_ws;
    void* args[] = {&p};
    hipError_t e = hipLaunchCooperativeKernel((const void*)mega_fwd, dim3(grid), dim3(NTHREADS), args, LDS_BYTES, stream);
    if (e != hipSuccess) fprintf(stderr, "kernel_launch: cooperative launch failed: %s (grid %d)\n", hipGetErrorString(e), grid);
}
```

```cpp
#ifndef DBG_ZERO_MASK
#endif
#ifndef DBG_C
#define DBG_C 5e-5f
#endif
#ifndef DBG_GPROF
#define DBG_GPROF -1
#endif
#ifndef DBG_GQ
#define DBG_GQ 0
#endif
#include <hip/hip_runtime.h>
#include <hip/hip_cooperative_groups.h>
#include <cstdio>
#include <cstdint>
namespace cg = cooperative_groups;

#define LAS __attribute__((address_space(3)))
typedef unsigned short bf16_t;
typedef short bf16x8 __attribute__((ext_vector_type(8)));
typedef short s16x4 __attribute__((ext_vector_type(4)));
typedef float f32x2 __attribute__((ext_vector_type(2)));
typedef float f32x4 __attribute__((ext_vector_type(4)));
typedef float f32x16 __attribute__((ext_vector_type(16)));
typedef unsigned u32x2 __attribute__((ext_vector_type(2)));
typedef unsigned u32x4 __attribute__((ext_vector_type(4)));
typedef int i32x4 __attribute__((ext_vector_type(4)));
typedef int i32x8 __attribute__((ext_vector_type(8)));

constexpr int D = 1024, NP = 4096, NS = 16384, NTOK = 20480, SEQ_P = 256, SEQ_S = 2048, PAST = 256;
constexpr int INW = 8224, FF = 2816, NE = 16, CAP_P = 512, CAP_S = 2048, SLOTS_E = 2560, NSLOT = NE * SLOTS_E;
constexpr float LN_EPS = 1e-6f;
constexpr int NTHREADS = 512, NWAVES = 8;
constexpr int LDS_BYTES = 147456;

enum { I_XP = 0, I_XS, I_CK, I_CV, I_SF, I_SB, I_C, I_CCTX, I_WMOD, I_BMOD, I_WIN, I_WAF, I_BAF, I_WAB, I_BAB, I_GLAG, I_WPA,
       I_LQ1, I_LK1, I_LQ2, I_LK2, I_SUBG, I_WPB, I_WOUT, I_LN1G, I_LN1B, I_WR, I_WEG, I_WEU, I_WED, I_LN2G, I_LN2B };

constexpr size_t O_YP = 0, O_YS = (size_t)NP * D, O_NK = (size_t)NTOK * D, O_NV = O_NK + (size_t)NP * D, O_NF = O_NV + (size_t)NP * D,
                 O_NB = O_NF + (size_t)16 * 4 * 128 * 256, O_END = O_NB + (size_t)16 * 4 * 128 * 256;

constexpr size_t H8_OFF = (size_t)4096 * 1024 * 2;
constexpr size_t al256(size_t x) { return (x + 255) / 256 * 256; }
constexpr size_t WS_CTL = 0;
constexpr size_t WS_MOD = 65536;
constexpr size_t WS_ROPE = WS_MOD + al256(9 * 6144 * 4 + 256);
constexpr size_t WS_AFAB = WS_ROPE + al256(3072 * 4);
constexpr size_t WS_AFF = WS_AFAB + (size_t)NTOK * 32 * 4;
constexpr size_t WS_SEL = WS_AFF + (size_t)NTOK * 16 * 4;
constexpr size_t WS_LIST = WS_SEL + (size_t)NTOK * 16 * 4;
constexpr size_t WS_GATE = WS_LIST + (size_t)NSLOT * 4;
constexpr size_t WS_CK = WS_GATE + (size_t)NSLOT * 4;
constexpr size_t WS_CV = WS_CK + (size_t)8 * 256 * 1024 * 2;
constexpr size_t WS_WIN = WS_CV + (size_t)8 * 256 * 1024 * 2;
constexpr size_t WS_WA = WS_WIN + (size_t)8192 * 1024 * 2;
constexpr size_t WS_WB = WS_WA + (size_t)1024 * 1024 * 2;
constexpr size_t WS_WO = WS_WB + (size_t)1024 * 1024 * 2;
constexpr size_t WS_WIN8 = WS_WO + (size_t)1024 * 1024 * 2;
constexpr size_t WS_WGU = WS_WIN8 + (size_t)8192 * 1024;
constexpr size_t WS_A = WS_WGU + (size_t)2 * NSLOT * 1024 * 2;
constexpr size_t SZ_T = (size_t)NTOK * 1024 * 2;
constexpr size_t WS_QA = WS_A, WS_KA = WS_QA + SZ_T / 2, WS_VA = WS_KA + SZ_T / 2, WS_QD = WS_VA + SZ_T, WS_KD = WS_QD + SZ_T,
                 WS_VD = WS_KD + SZ_T, WS_RA = WS_VD + SZ_T, WS_GA = WS_RA + SZ_T, WS_GB = WS_GA + SZ_T, WS_A_END = WS_GB + SZ_T;
constexpr size_t WS_MRG = WS_KD, WS_MIX = WS_VD, WS_H2 = WS_GA, WS_X1B = WS_GB, WS_HID = WS_A;
constexpr size_t WS_C = WS_A_END;
constexpr size_t WS_OCAT = WS_C, WS_OF = WS_OCAT + 2 * SZ_T, WS_OB = WS_OF + SZ_T, WS_END = WS_OB + SZ_T;
constexpr size_t WS_MRG2 = WS_OF;
constexpr size_t WS_MIX2 = WS_OB;
constexpr int ROW_LO = 16384;
constexpr size_t WS_WD = WS_WGU + (size_t)16 * 5632 * 1024;
constexpr size_t WS_YE = WS_WGU;
static_assert((size_t)NSLOT * FF <= WS_H2 - WS_A, "hid overlaps h2");
static_assert((size_t)16 * 5632 * 1024 + (size_t)16 * 1024 * FF <= (size_t)2 * NSLOT * 1024 * 2 && (size_t)NSLOT * 1024 * 2 <= (size_t)16 * 5632 * 1024, "expert weight / ye layout");
static_assert((size_t)16 * 5632 * 1024 <= (size_t)2 * NSLOT * 1024 * 2, "fp8 gate/up weights do not fit");
static_assert(WS_END <= 738197504ull, "workspace budget");

struct Params { const float* in[32]; float* out; unsigned char* ws; };

typedef __bf16 bf16x2_t __attribute__((ext_vector_type(2)));
__device__ __forceinline__ unsigned cvt_pk_bf16(float lo, float hi) { const f32x2 v = {lo, hi}; return __builtin_bit_cast(unsigned, __builtin_convertvector(v, bf16x2_t)); }
constexpr float S_W1 = 64.f, S_HID = 4.f, S_W2 = 128.f, S_WIN = 32.f, S_WP = 32.f, S_MRG = 4, S_YE = 32.f, S_MIX = 16.f;
__device__ __forceinline__ unsigned pk4_fp8(float a, float b, float c, float d) {
    a = __builtin_amdgcn_fmed3f(a, -440.f, 440.f); b = __builtin_amdgcn_fmed3f(b, -440.f, 440.f); c = __builtin_amdgcn_fmed3f(c, -440.f, 440.f); d = __builtin_amdgcn_fmed3f(d, -440.f, 440.f);
    int w = 0; w = __builtin_amdgcn_cvt_pk_fp8_f32(a, b, w, false); w = __builtin_amdgcn_cvt_pk_fp8_f32(c, d, w, true); return (unsigned)w;
}
__device__ __forceinline__ f32x4 fp8x4_f32(unsigned u) {
    const auto lo = __builtin_amdgcn_cvt_pk_f32_fp8((int)u, false), hi = __builtin_amdgcn_cvt_pk_f32_fp8((int)u, true); return (f32x4){lo[0], lo[1], hi[0], hi[1]};
}
__device__ __forceinline__ float bf2f(unsigned short b) { return __uint_as_float(((unsigned)b) << 16); }
__device__ __forceinline__ float bflo(unsigned w) { return __uint_as_float(w << 16); }
__device__ __forceinline__ float bfhi(unsigned w) { return __uint_as_float(w & 0xffff0000u); }
__device__ __forceinline__ float wave_sum(float v) {
#pragma unroll
    for (int o = 1; o < 64; o <<= 1) v += __shfl_xor(v, o);
    return v;
}
__device__ __forceinline__ float sigmoidf_(float x) { return __builtin_amdgcn_rcpf(1.0f + __expf(-x)); }
__device__ __forceinline__ float siluf_(float x) { return x * __builtin_amdgcn_rcpf(1.0f + __expf(-x)); }
#define LDS_WAIT() asm volatile("s_waitcnt lgkmcnt(0)" ::: "memory")

struct Frame {
    LAS unsigned char* lds;
    int tid, lane, wave, vcu, G;
    const Params* p;
};

__device__ __forceinline__ void transpose_item(const float* __restrict__ W, size_t ldn, bf16_t* __restrict__ WT, size_t ldk, int k0, int nsrc0, size_t drow0, LAS float* scr, int lane) {
#pragma unroll 8
    for (int i = 0; i < 32; ++i) { const int kk = 2 * i + (lane >> 5); scr[kk * 33 + (lane & 31)] = W[(size_t)(k0 + kk) * ldn + nsrc0 + (lane & 31)]; }
    LDS_WAIT(); asm volatile("" ::: "memory");
    const int c = lane & 7;
#pragma unroll
    for (int j = 0; j < 4; ++j) { const int n = (lane >> 3) + 8 * j; const LAS float* s = scr + (8 * c) * 33 + n;
        u32x4 o; o.x = cvt_pk_bf16(s[0 * 33], s[1 * 33]); o.y = cvt_pk_bf16(s[2 * 33], s[3 * 33]); o.z = cvt_pk_bf16(s[4 * 33], s[5 * 33]); o.w = cvt_pk_bf16(s[6 * 33], s[7 * 33]);
        *(u32x4*)(WT + (drow0 + n) * ldk + k0 + 8 * c) = o; }
    LDS_WAIT(); asm volatile("" ::: "memory");
}


struct TrItem { const float* W; bf16_t* WT; unsigned ldn, ldk; int k0, nsrc0; unsigned drow0, dstep; int kd0; int perm; };
__device__ __forceinline__ void tr_load(const TrItem& it, int wave, int lane, f32x4 (&v)[8]) {
    const float* p = it.W + (size_t)(it.k0 + 8 * wave) * it.ldn + it.nsrc0 + 4 * lane;
#pragma unroll
    for (int i = 0; i < 8; ++i) v[i] = *(const f32x4*)(p + (size_t)i * it.ldn);
}
__device__ __forceinline__ void tr_pack_write(LAS unsigned char* T, int wave, int lane, const f32x4 (&v)[8]) {
#pragma unroll
    for (int j = 0; j < 4; ++j) { u32x4 c; c.x = cvt_pk_bf16(v[0][j], v[1][j]); c.y = cvt_pk_bf16(v[2][j], v[3][j]); c.z = cvt_pk_bf16(v[4][j], v[5][j]); c.w = cvt_pk_bf16(v[6][j], v[7][j]);
        *(LAS u32x4*)(T + (4 * lane + j) * 128 + ((wave ^ (lane & 7)) << 4)) = c; }
}
__device__ __forceinline__ void tr_store(const TrItem& it, const LAS unsigned char* T, int tid) {
#pragma unroll
    for (int r = 0; r < 4; ++r) { const int idx = tid + 512 * r, n = idx >> 3, c = idx & 7;
        const u32x4 ch = *(const LAS u32x4*)(T + n * 128 + ((c ^ ((n >> 2) & 7)) << 4));
        *(u32x4*)(it.WT + (size_t)(it.drow0 + (unsigned)(n >> 7) * it.dstep + (unsigned)(n & 127)) * it.ldk + it.kd0 + 8 * c) = ch; }
}
constexpr int TR_IN = 16 * 32, TR_PR = 3 * 16 * 4, TR_GU = 2 * 16 * 16 * 11, TR_WD = 16 * 44 * 4;
__device__ __forceinline__ TrItem tr_item_p0(const Params& P, int r) {
    TrItem it;
    if (r < TR_IN) { const int kb = r >> 5, nb = r & 31, n0 = 256 * nb; it.W = P.in[I_WIN]; it.WT = (bf16_t*)(P.ws + WS_WIN); it.ldn = INW; it.ldk = 1024; it.k0 = 64 * kb; it.nsrc0 = n0 + (n0 >= 3072 ? 32 : 0); it.drow0 = n0; it.dstep = 128; it.kd0 = it.k0; it.perm = 0; }
    else { r -= TR_IN; const int w = r >> 6, q = r & 63, kb = q >> 2, nb = q & 3;
        it.W = (w == 0) ? P.in[I_WPA] : (w == 1) ? P.in[I_WPB] : P.in[I_WOUT]; it.WT = (bf16_t*)(P.ws + ((w == 2) ? WS_WO : WS_WA));
        it.ldn = 1024; it.ldk = (w == 2) ? 1024 : 2048; it.k0 = 64 * kb; it.kd0 = 64 * kb + (w == 1 ? 1024 : 0); it.nsrc0 = 256 * nb; it.drow0 = 256 * nb; it.dstep = 128; }
    return it;
}
__device__ __forceinline__ TrItem tr_item_gu(const Params& P, int r) {
    TrItem it; const int up = r / (TR_GU / 2), q = r % (TR_GU / 2), e = q / 176, q2 = q % 176, kb = q2 / 11, nb = q2 % 11;
    it.W = (up ? P.in[I_WEU] : P.in[I_WEG]) + (size_t)e * 1024 * FF; it.WT = (bf16_t*)(P.ws + WS_WGU); it.ldn = FF; it.ldk = 1024; it.k0 = 64 * kb; it.nsrc0 = 256 * nb;
    it.drow0 = (unsigned)e * 5632u + (unsigned)nb * 512u + (up ? 128u : 0u); it.dstep = 256; it.kd0 = it.k0; it.perm = 0; return it;
}
__device__ __forceinline__ TrItem tr_item_wd(const Params& P, int r) {
    TrItem it; const int e = r / 176, q = r % 176, kb = q >> 2, nb = q & 3;
    it.W = P.in[I_WED] + (size_t)e * FF * 1024; it.WT = (bf16_t*)(P.ws + WS_WD); it.ldn = 1024; it.ldk = FF; it.k0 = 64 * kb; it.nsrc0 = 256 * nb; it.drow0 = (unsigned)e * 1024u + 256u * nb; it.dstep = 128; it.kd0 = it.k0; it.perm = 0; return it;
}

__device__ __forceinline__ void tr8_load(const TrItem& it, int wave, int lane, f32x4 (&v)[16]) {
    const float* p = it.W + (size_t)it.k0 * it.ldn + it.nsrc0 + 4 * lane;
#pragma unroll
    for (int i = 0; i < 16; ++i) { const int q = 16 * wave + i, row = it.perm ? (q & 3) * 32 + (q >> 2) : q; v[i] = *(const f32x4*)(p + (size_t)row * it.ldn); }
}
__device__ __forceinline__ void tr8_pack_write(LAS unsigned char* T, int wave, int lane, const f32x4 (&v)[16], float sc) {
#pragma unroll
    for (int j = 0; j < 4; ++j) { u32x4 c; c.x = pk4_fp8(v[0][j] * sc, v[1][j] * sc, v[2][j] * sc, v[3][j] * sc); c.y = pk4_fp8(v[4][j] * sc, v[5][j] * sc, v[6][j] * sc, v[7][j] * sc);
        c.z = pk4_fp8(v[8][j] * sc, v[9][j] * sc, v[10][j] * sc, v[11][j] * sc); c.w = pk4_fp8(v[12][j] * sc, v[13][j] * sc, v[14][j] * sc, v[15][j] * sc);
        *(LAS u32x4*)(T + (4 * lane + j) * 128 + ((wave ^ (lane & 7)) << 4)) = c; }
}
__device__ __forceinline__ void tr8_store(const TrItem& it, const LAS unsigned char* T, int tid) {
#pragma unroll
    for (int r = 0; r < 4; ++r) { const int idx = tid + 512 * r, n = idx >> 3, c = idx & 7;
        const u32x4 ch = *(const LAS u32x4*)(T + n * 128 + ((c ^ ((n >> 2) & 7)) << 4));
        *(u32x4*)((unsigned char*)it.WT + (size_t)(it.drow0 + (unsigned)(n >> 7) * it.dstep + (unsigned)(n & 127)) * it.ldk + it.kd0 + 16 * c) = ch; }
}
constexpr int TR8_GU = 2 * 16 * 8 * 11, TR8_WD = 16 * 22 * 4, TR8_IN = 8 * 32, TR8_PR = 4 * 8 * 4;
__device__ __forceinline__ TrItem tr8_item_pr(const Params& P, int r) {
    TrItem it; const int w = r >> 5, q = r & 31, kb = q >> 2, nb = q & 3;
    it.W = (w == 0) ? P.in[I_WPA] : (w == 1) ? P.in[I_WPB] : P.in[I_WOUT]; it.WT = (bf16_t*)(P.ws + ((w >= 2) ? WS_WO : WS_WA));
    it.ldn = 1024; it.ldk = 2048; it.k0 = 128 * kb; it.kd0 = 128 * kb + ((w & 1) ? 1024 : 0); it.nsrc0 = 256 * nb; it.drow0 = 256 * nb; it.dstep = 128; it.perm = (w == 1); return it;
}
__device__ __forceinline__ TrItem tr8_item_in(const Params& P, int r) {
    TrItem it; const int kb = r >> 5, nb = r & 31, n0 = 256 * nb;
    it.W = P.in[I_WIN]; it.WT = (bf16_t*)(P.ws + WS_WIN8); it.ldn = INW; it.ldk = 1024; it.k0 = 128 * kb; it.kd0 = it.k0; it.nsrc0 = n0 + (n0 >= 3072 ? 32 : 0); it.drow0 = n0; it.dstep = 128; it.perm = 0; return it;
}
__device__ __forceinline__ TrItem tr8_item_gu(const Params& P, int r) {
    TrItem it; const int up = r / (TR8_GU / 2), q = r % (TR8_GU / 2), e = q / 88, q2 = q % 88, kb = q2 / 11, nb = q2 % 11;
    it.W = (up ? P.in[I_WEU] : P.in[I_WEG]) + (size_t)e * 1024 * FF; it.WT = (bf16_t*)(P.ws + WS_WGU); it.ldn = FF; it.ldk = 1024; it.k0 = 128 * kb; it.nsrc0 = 256 * nb;
    it.drow0 = (unsigned)e * 5632u + (unsigned)nb * 512u + (up ? 128u : 0u); it.dstep = 256; it.kd0 = it.k0; it.perm = 0; return it;
}
__device__ __forceinline__ TrItem tr8_item_wd(const Params& P, int r) {
    TrItem it; const int e = r / 88, q = r % 88, kb = q >> 2, nb = q & 3;
    it.W = P.in[I_WED] + (size_t)e * FF * 1024; it.WT = (bf16_t*)(P.ws + WS_WD); it.ldn = 1024; it.ldk = FF; it.k0 = 128 * kb; it.nsrc0 = 256 * nb; it.drow0 = (unsigned)e * 1024u + 256u * nb; it.dstep = 128; it.kd0 = it.k0; it.perm = 0; return it;
}
template <int KIND> __device__ __forceinline__ void tr_run(const Params& P, LAS unsigned char* T, int tid, int first, int stride, int limit) {
    const int wave = tid >> 6, lane = tid & 63;
    if (first >= limit) return;
    if constexpr (KIND == 0) {
        f32x4 v[8]; TrItem it = tr_item_p0(P, first);
        tr_load(it, wave, lane, v);
        for (int r = first; r < limit; r += stride) {
            tr_pack_write(T, wave, lane, v);
            const TrItem cur = it;
            if (r + stride < limit) { it = tr_item_p0(P, r + stride); tr_load(it, wave, lane, v); }
            __syncthreads();
            tr_store(cur, T, tid);
            __syncthreads();
        }
    } else {
        constexpr float sc = (KIND == 1) ? S_W1 : (KIND == 2) ? S_W2 : (KIND == 3) ? S_WIN : S_WP;
        f32x4 v[16]; TrItem it = (KIND == 1) ? tr8_item_gu(P, first) : (KIND == 2) ? tr8_item_wd(P, first) : (KIND == 3) ? tr8_item_in(P, first) : tr8_item_pr(P, first);
        tr8_load(it, wave, lane, v);
        for (int r = first; r < limit; r += stride) {
            tr8_pack_write(T, wave, lane, v, sc);
            const TrItem cur = it;
            if (r + stride < limit) { it = (KIND == 1) ? tr8_item_gu(P, r + stride) : (KIND == 2) ? tr8_item_wd(P, r + stride) : (KIND == 3) ? tr8_item_in(P, r + stride) : tr8_item_pr(P, r + stride); tr8_load(it, wave, lane, v); }
            __syncthreads();
            tr8_store(cur, T, tid);
            __syncthreads();
        }
    }
}


constexpr int CONV_TOTAL = TR8_GU + TR8_WD;
__device__ __forceinline__ TrItem conv_decode(const Params& P, int item) { return (item < TR8_GU) ? tr8_item_gu(P, item) : tr8_item_wd(P, item - TR8_GU); }
#define CONV_WAIT(N, v) asm volatile("s_waitcnt vmcnt(" #N ")" : "+v"(v[0]), "+v"(v[1]), "+v"(v[2]), "+v"(v[3]), "+v"(v[4]), "+v"(v[5]), "+v"(v[6]), "+v"(v[7]), \
        "+v"(v[8]), "+v"(v[9]), "+v"(v[10]), "+v"(v[11]), "+v"(v[12]), "+v"(v[13]), "+v"(v[14]), "+v"(v[15]) :: "memory")
__device__ __forceinline__ void tr8_load_async(const TrItem& it, int wave, int lane, f32x4 (&v)[16]) {
    const float* p = it.W + ((size_t)it.k0 + 16 * wave) * it.ldn + it.nsrc0 + 4 * lane;
#pragma unroll
    for (int i = 0; i < 16; ++i) { const float* q = p + (size_t)i * it.ldn; asm volatile("global_load_dwordx4 %0, %1, off" : "=v"(v[i]) : "v"(q) : "memory"); }
}
__device__ __forceinline__ void conv_batch(const Params& P, LAS unsigned char* T, int tid_in, int base, int n) {
    int tid = tid_in; asm volatile("" : "+v"(tid));
    const int wave = tid >> 6, lane = tid & 63;
    if (base + n > CONV_TOTAL) n = CONV_TOTAL - base;
    if (n <= 0) return;
    const int last = base + n - 1;
#define CONV_IDX(j) ((base + (j) < last) ? base + (j) : last)
    asm volatile("s_waitcnt vmcnt(0)" ::: "memory");
    f32x4 va[16], vb[16]; int xa = CONV_IDX(0), xb = CONV_IDX(1);
    TrItem ia = conv_decode(P, xa), ib = conv_decode(P, xb);
    tr8_load_async(ia, wave, lane, va);
    tr8_load_async(ib, wave, lane, vb);
    CONV_WAIT(16, va);
    for (int j = 0; j < n; j += 2) {
        const TrItem ca = ia, cb = ib;
        CONV_WAIT(24, va);
        tr8_pack_write(T, wave, lane, va, (xa < TR8_GU) ? S_W1 : S_W2);
        xa = CONV_IDX(j + 2); ia = conv_decode(P, xa); tr8_load_async(ia, wave, lane, va);
        __syncthreads();
        tr8_store(ca, T, tid);
        CONV_WAIT(20, vb);
        tr8_pack_write(T + 32768, wave, lane, vb, (xb < TR8_GU) ? S_W1 : S_W2);
        xb = CONV_IDX(j + 3); ib = conv_decode(P, xb); tr8_load_async(ib, wave, lane, vb);
        __syncthreads();
        tr8_store(cb, T + 32768, tid);
    }
#undef CONV_IDX
    CONV_WAIT(0, va); CONV_WAIT(0, vb);
    __syncthreads();
}

__device__ __forceinline__ void tr16_pack_write(LAS unsigned char* T, int wave, int lane, const f32x4 (&v)[16]) {
#pragma unroll
    for (int j = 0; j < 4; ++j)
#pragma unroll
        for (int h = 0; h < 2; ++h) { u32x4 c; c.x = cvt_pk_bf16(v[8 * h + 0][j], v[8 * h + 1][j]); c.y = cvt_pk_bf16(v[8 * h + 2][j], v[8 * h + 3][j]); c.z = cvt_pk_bf16(v[8 * h + 4][j], v[8 * h + 5][j]); c.w = cvt_pk_bf16(v[8 * h + 6][j], v[8 * h + 7][j]);
            *(LAS u32x4*)(T + (4 * lane + j) * 256 + (((2 * wave + h) ^ (lane & 15)) << 4)) = c; }
}
__device__ __forceinline__ void tr16_store(const TrItem& it, bf16_t* WT, const LAS unsigned char* T, int tid) {
#pragma unroll
    for (int r = 0; r < 8; ++r) { const int idx = tid + 512 * r, n = idx >> 4, c = idx & 15;
        const u32x4 ch = *(const LAS u32x4*)(T + n * 256 + ((c ^ ((n >> 2) & 15)) << 4));
        *(u32x4*)(WT + (size_t)(it.drow0 + (unsigned)(n >> 7) * it.dstep + (unsigned)(n & 127)) * it.ldk + it.kd0 + 8 * c) = ch; }
}
__device__ __forceinline__ void p0_prologue(Frame& F) {
    const Params& P = *F.p;
    unsigned char* ws = P.ws;
    LAS float* ldsf = (LAS float*)F.lds;
    const int c = F.vcu;
    const TrItem itw = tr8_item_in(P, (c < TR8_IN) ? c : 0);
    f32x4 vw[16], vp[16];
    tr8_load(itw, F.wave, F.lane, vw);
    const TrItem itp = tr8_item_pr(P, (c < TR8_PR) ? c : 0);
    if (c < TR8_PR) tr8_load(itp, F.wave, F.lane, vp);
    if (c < 192) {
        const float* cc = P.in[I_C]; const float* cctx = P.in[I_CCTX]; const float* wm = P.in[I_WMOD]; const float* bm = P.in[I_BMOD];
        { float cv[18];
#pragma unroll
          for (int j = 0; j < 18; ++j) { const int i = F.tid + NTHREADS * j, r = i >> 10, k = i & 1023; cv[j] = (r == 0) ? cctx[k] : cc[(r - 1) * 1024 + k]; }
#pragma unroll
          for (int j = 0; j < 18; ++j) ldsf[F.tid + NTHREADS * j] = siluf_(cv[j]); }
        __syncthreads();
        const int col = F.tid & 31, kg = F.tid >> 5, k0 = kg * 64;
        float acc[9];
#pragma unroll
        for (int r = 0; r < 9; ++r) acc[r] = 0.f;
#pragma unroll
        for (int kh = 0; kh < 64; kh += 32) { float wv[32];
#pragma unroll
          for (int kk = 0; kk < 32; ++kk) wv[kk] = wm[(size_t)(k0 + kh + kk) * 6144 + 32 * c + col];
          asm volatile("" ::: "memory");
#pragma unroll
          for (int kk = 0; kk < 32; kk += 4) {
#pragma unroll
            for (int r = 0; r < 9; ++r) { const f32x4 a = *(const LAS f32x4*)(ldsf + r * 1024 + k0 + kh + kk);
                acc[r] = fmaf(a.x, wv[kk], acc[r]); acc[r] = fmaf(a.y, wv[kk + 1], acc[r]); acc[r] = fmaf(a.z, wv[kk + 2], acc[r]); acc[r] = fmaf(a.w, wv[kk + 3], acc[r]); } } }
        LAS float* red = ldsf + 9 * 1024;
#pragma unroll
        for (int r = 0; r < 9; ++r) red[(kg * 9 + r) * 32 + col] = acc[r];
        __syncthreads();
        if (F.tid < 288) { const int r = F.tid >> 5, cl = F.tid & 31; float s = 0.f;
#pragma unroll
            for (int g = 0; g < 16; ++g) s += red[(g * 9 + r) * 32 + cl];
            ((float*)(ws + WS_MOD))[r * 6144 + 32 * c + cl] = s + bm[32 * c + cl]; }
        __syncthreads();
    } else if (c == 192) {
        if (F.wave == 0) {
            const float* q1 = P.in[I_LQ1]; const float* k1 = P.in[I_LK1]; const float* q2 = P.in[I_LQ2]; const float* k2 = P.in[I_LK2];
            const float s1 = wave_sum(q1[F.lane] * k1[F.lane]), s2 = wave_sum(q2[F.lane] * k2[F.lane]);
            if (F.lane == 0) ((float*)(ws + WS_MOD))[9 * 6144] = expf(s1) - expf(s2) + 0.2f;
        }
        float* rope = (float*)(ws + WS_ROPE);
        for (int i = F.tid; i < 96 * 16; i += NTHREADS) {
            const int pos = i >> 4, j = i & 15;
            const float inv = powf(10000.0f, -(float)j / 16.0f);
            const float p = (pos < 32) ? (float)pos : (float)(pos - 32);
            float sn, cs; sincosf(p * inv, &sn, &cs);
            if (pos < 32) { rope[pos * 16 + j] = cs; rope[512 + pos * 16 + j] = sn; }
            else { rope[1024 + (pos - 32) * 16 + j] = cs; rope[2048 + (pos - 32) * 16 + j] = sn; }
        }
    }
    __syncthreads();
    const size_t n8 = (size_t)8 * 256 * 1024 / 8;
    f32x4 ca[4], cb[4];
#pragma unroll
    for (int q = 0; q < 4; ++q) { const size_t i = (size_t)F.vcu * NTHREADS + F.tid + (size_t)q * F.G * NTHREADS;
        if (i < 2 * n8) { const bool isk = i < n8; const size_t j = isk ? i : i - n8; const float* src = (isk ? P.in[I_CK] : P.in[I_CV]) + j * 8; ca[q] = *(const f32x4*)src; cb[q] = *(const f32x4*)(src + 4); } }
    if (c < TR8_IN) {
        const int nb = c & 31; const bool need16 = (nb >= 2 && nb < 8) || (nb >= 16 && nb < 24);
        tr8_pack_write(F.lds, F.wave, F.lane, vw, S_WIN);
        if (need16) tr16_pack_write(F.lds + 32768, F.wave, F.lane, vw);
        __syncthreads();
        tr8_store(itw, F.lds, F.tid);
        if (need16) tr16_store(itw, (bf16_t*)(P.ws + WS_WIN), F.lds + 32768, F.tid);
        __syncthreads();
    }
    for (int r = c + F.G; r < TR8_IN; r += F.G) {
        const TrItem it2 = tr8_item_in(P, r); tr8_load(it2, F.wave, F.lane, vw);
        tr8_pack_write(F.lds, F.wave, F.lane, vw, S_WIN); tr16_pack_write(F.lds + 32768, F.wave, F.lane, vw);
        __syncthreads();
        tr8_store(it2, F.lds, F.tid); tr16_store(it2, (bf16_t*)(P.ws + WS_WIN), F.lds + 32768, F.tid);
        __syncthreads();
    }
    if (c < TR8_PR) {
        tr8_pack_write(F.lds, F.wave, F.lane, vp, S_WP);
        __syncthreads();
        tr8_store(itp, F.lds, F.tid);
        __syncthreads();
    }
    tr_run<4>(P, F.lds, F.tid, F.vcu + F.G, F.G, TR8_PR);
    {
#pragma unroll
        for (int q = 0; q < 4; ++q) { const size_t i = (size_t)F.vcu * NTHREADS + F.tid + (size_t)q * F.G * NTHREADS;
            if (i < 2 * n8) { const bool isk = i < n8; const size_t j = isk ? i : i - n8; const f32x4 a = ca[q], b = cb[q];
                u32x4 o; o.x = cvt_pk_bf16(a.x, a.y); o.y = cvt_pk_bf16(a.z, a.w); o.z = cvt_pk_bf16(b.x, b.y); o.w = cvt_pk_bf16(b.z, b.w);
                *(u32x4*)(ws + (isk ? WS_CK : WS_CV) + j * 16) = o; } }
        for (size_t i = (size_t)F.vcu * NTHREADS + F.tid + (size_t)4 * F.G * NTHREADS; i < 2 * n8; i += (size_t)F.G * NTHREADS) {
            const bool isk = i < n8; const size_t j = isk ? i : i - n8;
            const float* src = (isk ? P.in[I_CK] : P.in[I_CV]) + j * 8;
            const f32x4 a = *(const f32x4*)src, b = *(const f32x4*)(src + 4);
            u32x4 o; o.x = cvt_pk_bf16(a.x, a.y); o.y = cvt_pk_bf16(a.z, a.w); o.z = cvt_pk_bf16(b.x, b.y); o.w = cvt_pk_bf16(b.z, b.w);
            *(u32x4*)(ws + (isk ? WS_CK : WS_CV) + j * 16) = o;
        }
    }
}

__device__ __forceinline__ const float* xrow_ptr(const Params& P, int m) { return (m < NP) ? P.in[I_XP] + (size_t)m * D : P.in[I_XS] + (size_t)(m - NP) * D; }
__device__ __forceinline__ int mod_row(int m) { return (m < NP) ? 0 : 1 + ((m - NP) >> 11); }

__device__ __forceinline__ void p1_ln0(Frame& F) {
    const Params& P = *F.p;
    constexpr int RS = 2064;
    LAS unsigned char* WT = F.lds;
    LAS unsigned char* HT = F.lds + 32 * RS;
    LAS f32x4* RED = (LAS f32x4*)(F.lds + 48 * RS);
    const float* win = P.in[I_WIN];
    { f32x4 wv[16];
#pragma unroll
      for (int j = 0; j < 16; ++j) { const int idx = F.tid + NTHREADS * j, k = idx >> 3, c4 = idx & 7; wv[j] = *(const f32x4*)(win + (size_t)k * INW + 3072 + 4 * c4); }
#pragma unroll
      for (int j = 0; j < 16; ++j) { const int idx = F.tid + NTHREADS * j, k = idx >> 3, c4 = idx & 7;
#pragma unroll
        for (int t = 0; t < 4; ++t) *(LAS unsigned short*)(WT + (4 * c4 + t) * RS + k * 2) = (unsigned short)(cvt_pk_bf16(wv[j][t], 0.f) & 0xffffu); } }
    __syncthreads();
    const float* mod = (const float*)(P.ws + WS_MOD);
    bf16_t* H = (bf16_t*)P.out;
    float* afab = (float*)(P.ws + WS_AFAB);
    const int lane = F.lane, w = F.wave;
    f32x4 xq[2][4];
#define P1_LOAD(BLK) do { _Pragma("unroll") for (int rr = 0; rr < 2; ++rr) _Pragma("unroll") for (int j = 0; j < 4; ++j) xq[rr][j] = *((const f32x4*)xrow_ptr(P, (BLK) * 16 + 2 * w + rr) + lane + 64 * j); } while (0)
    if (F.vcu < NTOK / 16) P1_LOAD(F.vcu);
    for (int blk = F.vcu; blk < NTOK / 16; blk += F.G) {
        const int row0 = blk * 16, mr = mod_row(row0);
        f32x4 hq[2][4], msh[4], msc[4];
#pragma unroll
        for (int j = 0; j < 4; ++j) { msh[j] = *((const f32x4*)(mod + mr * 6144) + lane + 64 * j); msc[j] = *((const f32x4*)(mod + mr * 6144 + 1024) + lane + 64 * j); }
#pragma unroll
        for (int rr = 0; rr < 2; ++rr)
#pragma unroll
            for (int j = 0; j < 4; ++j) hq[rr][j] = xq[rr][j];
        asm volatile("" :: "v"(msh[0]), "v"(msh[1]), "v"(msh[2]), "v"(msh[3]), "v"(msc[0]), "v"(msc[1]), "v"(msc[2]), "v"(msc[3]));
        if (blk + F.G < NTOK / 16) P1_LOAD(blk + F.G);
#pragma unroll
        for (int rr = 0; rr < 2; ++rr) {
            const int m = row0 + 2 * w + rr;
            f32x4 h[4]; float s = 0.f;
#pragma unroll
            for (int j = 0; j < 4; ++j) { h[j] = hq[rr][j]; s += (h[j].x + h[j].y) + (h[j].z + h[j].w); }
            const float mean = wave_sum(s) * (1.f / D); float s2 = 0.f;
#pragma unroll
            for (int j = 0; j < 4; ++j) { h[j] = h[j] - mean; s2 += (h[j].x * h[j].x + h[j].y * h[j].y) + (h[j].z * h[j].z + h[j].w * h[j].w); }
            const float rstd = 1.f / sqrtf(wave_sum(s2) * (1.f / D) + LN_EPS);
            u32x2* o8 = (u32x2*)(H + (size_t)m * D) + lane;
            unsigned* o4 = (unsigned*)((unsigned char*)P.out + H8_OFF + (size_t)m * D) + lane;
#pragma unroll
            for (int j = 0; j < 4; ++j) {
                const f32x4 sh = msh[j], sc = msc[j];
                h[j] = h[j] * rstd * (sc + 1.0f) + sh;
                u32x2 wv; wv.x = cvt_pk_bf16(h[j].x, h[j].y); wv.y = cvt_pk_bf16(h[j].z, h[j].w);
                if (m < NP) o8[64 * j] = wv;
                o4[64 * j] = pk4_fp8(h[j].x, h[j].y, h[j].z, h[j].w);
                *(LAS u32x2*)(HT + (2 * w + rr) * RS + (4 * lane + 256 * j) * 2) = wv;
            }
        }
        __syncthreads();
        f32x4 acc0 = {0.f, 0.f, 0.f, 0.f}, acc1 = {0.f, 0.f, 0.f, 0.f};
#pragma unroll
        for (int ks = 0; ks < 4; ++ks) { const int kb = (128 * w + 32 * ks + 8 * (lane >> 4)) * 2;
            const bf16x8 a = *(const LAS bf16x8*)(HT + (lane & 15) * RS + kb);
            const bf16x8 b0 = *(const LAS bf16x8*)(WT + (lane & 15) * RS + kb), b1 = *(const LAS bf16x8*)(WT + (16 + (lane & 15)) * RS + kb);
            acc0 = __builtin_amdgcn_mfma_f32_16x16x32_bf16(a, b0, acc0, 0, 0, 0); acc1 = __builtin_amdgcn_mfma_f32_16x16x32_bf16(a, b1, acc1, 0, 0, 0); }
        RED[(w * 2 + 0) * 64 + lane] = acc0; RED[(w * 2 + 1) * 64 + lane] = acc1;
        __syncthreads();
        { const int r = F.tid >> 5, c = F.tid & 31, nb = c >> 4, ln = (r >> 2) * 16 + (c & 15), rg = r & 3; float sum = 0.f;
#pragma unroll
          for (int ww = 0; ww < 8; ++ww) sum += RED[(ww * 2 + nb) * 64 + ln][rg];
          afab[(size_t)(row0 + r) * 32 + c] = sum; }
        __syncthreads();
    }
}

#define TR_STEP(O, HALF) { const bool up = (lane & (O)) != 0; _Pragma("unroll") for (int i = 0; i < (HALF); ++i) { const float a = vals[i], b = vals[i + (HALF)]; \
            const float send = up ? a : b, keep = up ? b : a; vals[i] = keep + __shfl_xor(send, (O)); } }

namespace pg8 {
constexpr int BM = 256, BK = 64, HALF = 128, HTB = HALF * BK * 2, STAGE_BYTES = 8 * HTB, NXCD = 8, WGM = 8;
__device__ __forceinline__ int lds_byte(int r, int c) { const int st = (r >> 4) * 2 + (c >> 5), rr = r & 15, cc = c & 31, ob = rr * 64 + cc * 2; return st * 1024 + (ob ^ (((ob >> 9) & 1) << 5)); }
__device__ __forceinline__ void stage_rc(int b, int& R, int& C) { const int st = b / 1024, sb = b % 1024, swz = sb ^ (((sb >> 9) & 1) << 5); R = (st >> 1) * 16 + swz / 64; C = (st & 1) * 32 + (swz % 64) / 2; }
__device__ __forceinline__ int perm32(int rho) { const int n = rho >> 4, i = rho & 15; return 8 * (i >> 2) + 4 * n + (i & 3); }

template <bool FP8> struct FragT { typedef bf16x8 type; };
template <> struct FragT<true> { typedef i32x4 type; };
template <bool FP8, class F> __device__ __forceinline__ void mma_step(f32x4& acc, const F& b0, const F& b1, const F& a0, const F& a1) {
    if constexpr (FP8) {
        const i32x8 b = __builtin_shufflevector(b0, b1, 0, 1, 2, 3, 4, 5, 6, 7), a = __builtin_shufflevector(a0, a1, 0, 1, 2, 3, 4, 5, 6, 7);
        const int one = 0x7f7f7f7f;
        asm volatile("v_mfma_scale_f32_16x16x128_f8f6f4 %0, %1, %2, %0, %3, %3 op_sel_hi:[0,0,0]" : "+v"(acc) : "v"(b), "v"(a), "v"(one));
    } else {
        acc = __builtin_amdgcn_mfma_f32_16x16x32_bf16(b0, a0, acc, 0, 0, 0);
        acc = __builtin_amdgcn_mfma_f32_16x16x32_bf16(b1, a1, acc, 0, 0, 0);
    }
}
template <class Sched, class Epi, bool FP8 = false>
__device__ __forceinline__ void gemm_phase(LAS unsigned char* lds, const Sched& S, const Epi& E, const int tid, unsigned long long* prof = nullptr) {
    unsigned long long t_k = 0, t_e = 0, t_mark = prof ? __builtin_amdgcn_s_memrealtime() : 0ull; const unsigned long long t_begin = t_mark;
    const int wid = __builtin_amdgcn_readfirstlane(tid >> 6), lane = tid & 63, wr = wid >> 2, wc = wid & 3, fr = lane & 15, fq = lane >> 4;
    constexpr unsigned ES = FP8 ? 1u : 2u;
    int Rr[2], Cc[2]; unsigned voffB[2];
#pragma unroll
    for (int i = 0; i < 2; ++i) { int R, C; stage_rc(tid * 16 + i * 8192, R, C); Rr[i] = R; Cc[i] = C; const int Rb = (R & ~31) + perm32(R & 31); voffB[i] = (unsigned)(Rb * S.ldb) * ES + (unsigned)C * 2u; }
    const size_t kstep = (size_t)(BK * 2);
    const size_t hstepB = (size_t)HALF * S.ldb * ES;
    const unsigned ldsw = (unsigned)wid * 1024u;
    const int aoff = lds_byte(wr * 64 + fr, fq * 8), boff = lds_byte(wc * 32 + fr, fq * 8);
#define PG8_SA(b, h) (((b) * 2 + (h)) * HTB)
#define PG8_SB(b, h) ((4 + (b) * 2 + (h)) * HTB)
#define PG8_STAGE(bufoff, gbase, voff) do { _Pragma("unroll") for (int _i = 0; _i < 2; ++_i) \
        __builtin_amdgcn_global_load_lds((const unsigned*)((const char*)(gbase) + (voff)[_i]), (LAS unsigned*)(lds + (bufoff) + ldsw + _i * 8192), 16, 0, 0); } while (0)
#define PG8_LDA(dst, b, h) do { _Pragma("unroll") for (int m = 0; m < 4; ++m) _Pragma("unroll") for (int k = 0; k < 2; ++k) dst[m][k] = *(const LAS frag_t*)(lds + PG8_SA(b, h) + aoff + m * 2048 + k * 1024); } while (0)
#define PG8_LDB(dst, b, h) do { _Pragma("unroll") for (int n = 0; n < 2; ++n) _Pragma("unroll") for (int k = 0; k < 2; ++k) dst[n][k] = *(const LAS frag_t*)(lds + PG8_SB(b, h) + boff + n * 2048 + k * 1024); } while (0)
#define PG8_MMA(ai, bj, At, Bt) do { __builtin_amdgcn_s_setprio(1); _Pragma("unroll") for (int m = 0; m < 4; ++m) _Pragma("unroll") for (int n = 0; n < 2; ++n) \
        mma_step<FP8>(acc[ai][bj][m][n], Bt[n][0], Bt[n][1], At[m][0], At[m][1]); \
        __builtin_amdgcn_s_setprio(0); } while (0)
#define PG8_WAIT_V(n) asm volatile("s_waitcnt vmcnt(" #n ")" ::: "memory")
#define PG8_WAIT_L(n) asm volatile("s_waitcnt lgkmcnt(" #n ")" ::: "memory")
#define PG8_BAR __builtin_amdgcn_s_barrier()
#define PG8_SCHED __builtin_amdgcn_sched_barrier(0)
#define PG8_VOFFA(dst, u) do { _Pragma("unroll") for (int _h = 0; _h < 2; ++_h) _Pragma("unroll") for (int _i = 0; _i < 2; ++_i) \
        dst[_h][_i] = (unsigned)(S.a_row(u, _h * HALF + Rr[_i]) * (unsigned)S.lda) * ES + (unsigned)Cc[_i] * 2u; } while (0)
    typename Sched::U cur, nxt; int ui = 0;
    if (!S.next(0, cur)) return;
    f32x4 acc[2][2][4][2];
#pragma unroll
    for (int a = 0; a < 2; ++a)
#pragma unroll
        for (int b = 0; b < 2; ++b)
#pragma unroll
            for (int m = 0; m < 4; ++m)
#pragma unroll
                for (int n = 0; n < 2; ++n) acc[a][b][m][n] = (f32x4){0.f, 0.f, 0.f, 0.f};
    typedef typename FragT<FP8>::type frag_t;
    frag_t At[4][2], B0[2][2], B1[2][2];
    unsigned vA[2][2], vAn[2][2];
    PG8_VOFFA(vA, cur);
    const char* cA = S.a_base(cur); const char* cB = S.b_base(cur);
    PG8_STAGE(PG8_SB(0, 0), cB, voffB); PG8_STAGE(PG8_SA(0, 0), cA, vA[0]); PG8_STAGE(PG8_SB(0, 1), cB + hstepB, voffB); PG8_STAGE(PG8_SA(0, 1), cA, vA[1]);
    if (wr == 1) PG8_BAR;
    PG8_WAIT_V(4); PG8_BAR;
    PG8_STAGE(PG8_SB(1, 0), cB + kstep, voffB); PG8_STAGE(PG8_SA(1, 0), cA + kstep, vA[0]); PG8_STAGE(PG8_SB(1, 1), cB + hstepB + kstep, voffB);
    PG8_WAIT_V(6); PG8_BAR;
    for (;;) {
        const bool has_next = S.next(ui + 1, nxt);
        const int nt = S.nt_u(cur);
        const char* nA = has_next ? S.a_base(nxt) : cA; const char* nB = has_next ? S.b_base(nxt) : cB;
        if (has_next) { PG8_VOFFA(vAn, nxt); } else {
#pragma unroll
            for (int h = 0; h < 2; ++h)
#pragma unroll
                for (int i = 0; i < 2; ++i) vAn[h][i] = vA[h][i]; }
        for (int t = 0; t < nt; t += 2) {
            if constexpr (Epi::HAS_MID) { if (t == Epi::MID_T) { if constexpr (FP8) asm volatile("s_nop 15\n\ts_nop 15" ::: "memory"); E.mid(acc, cur, wr, wc, fr, fq); } }
            const bool last = (t == nt - 2);
            const char* a1 = cA + (size_t)(t + 1) * kstep;
            const char* a2 = last ? nA : cA + (size_t)(t + 2) * kstep; const char* b2 = last ? nB : cB + (size_t)(t + 2) * kstep;
            const char* a3 = a2 + kstep; const char* b3 = b2 + kstep;
            unsigned v2[2][2];
#pragma unroll
            for (int h = 0; h < 2; ++h)
#pragma unroll
                for (int i = 0; i < 2; ++i) v2[h][i] = last ? vAn[h][i] : vA[h][i];
            PG8_LDB(B0, 0, 0); PG8_SCHED; PG8_LDA(At, 0, 0); PG8_STAGE(PG8_SA(1, 1), a1, vA[1]);
            PG8_WAIT_L(8); PG8_BAR; PG8_WAIT_L(0); PG8_MMA(0, 0, At, B0); PG8_BAR; PG8_SCHED;
            PG8_LDB(B1, 0, 1); PG8_STAGE(PG8_SB(0, 0), b2, voffB);
            PG8_BAR; PG8_WAIT_L(0); PG8_MMA(0, 1, At, B1); PG8_BAR;
            PG8_LDA(At, 0, 1); PG8_STAGE(PG8_SA(0, 0), a2, v2[0]);
            PG8_BAR; PG8_WAIT_L(0); PG8_MMA(1, 0, At, B0); PG8_BAR; PG8_SCHED;
            PG8_STAGE(PG8_SB(0, 1), b2 + hstepB, voffB);
            PG8_WAIT_V(6); PG8_BAR; PG8_MMA(1, 1, At, B1); PG8_BAR;
            PG8_LDB(B0, 1, 0); PG8_SCHED; PG8_LDA(At, 1, 0); PG8_STAGE(PG8_SA(0, 1), a2, v2[1]);
            PG8_WAIT_L(8); PG8_BAR; PG8_WAIT_L(0); PG8_MMA(0, 0, At, B0); PG8_BAR; PG8_SCHED;
            PG8_LDB(B1, 1, 1); PG8_STAGE(PG8_SB(1, 0), b3, voffB);
            PG8_BAR; PG8_WAIT_L(0); PG8_MMA(0, 1, At, B1); PG8_BAR;
            PG8_LDA(At, 1, 1); PG8_STAGE(PG8_SA(1, 0), a3, v2[0]);
            PG8_BAR; PG8_WAIT_L(0); PG8_MMA(1, 0, At, B0); PG8_BAR; PG8_SCHED;
            PG8_STAGE(PG8_SB(1, 1), b3 + hstepB, voffB);
            PG8_WAIT_V(6); PG8_BAR; PG8_MMA(1, 1, At, B1); PG8_BAR;
        }
        if (prof) { const unsigned long long t = __builtin_amdgcn_s_memrealtime(); t_k += t - t_mark; t_mark = t; }
        if constexpr (FP8) asm volatile("s_nop 15\n\ts_nop 15" ::: "memory");
        E(acc, cur, wr, wc, fr, fq);
        if (prof) { asm volatile("s_waitcnt vmcnt(0)" ::: "memory"); const unsigned long long t = __builtin_amdgcn_s_memrealtime(); t_e += t - t_mark; t_mark = t; }
        if (!has_next) break;
#pragma unroll
        for (int a = 0; a < 2; ++a)
#pragma unroll
            for (int b = 0; b < 2; ++b)
#pragma unroll
                for (int m = 0; m < 4; ++m)
#pragma unroll
                    for (int n = 0; n < 2; ++n) acc[a][b][m][n] = (f32x4){0.f, 0.f, 0.f, 0.f};
        cur = nxt; cA = nA; cB = nB; ++ui;
#pragma unroll
        for (int h = 0; h < 2; ++h)
#pragma unroll
            for (int i = 0; i < 2; ++i) vA[h][i] = vAn[h][i];
    }
    PG8_WAIT_V(0);
    if (wr == 0) PG8_BAR;
    PG8_BAR;
    if (prof && blockIdx.x == 0 && tid == 0) { prof[0] = t_k; prof[1] = t_e; prof[2] = __builtin_amdgcn_s_memrealtime() - t_begin; }
#undef PG8_SA
#undef PG8_SB
#undef PG8_STAGE
#undef PG8_LDA
#undef PG8_LDB
#undef PG8_MMA
#undef PG8_WAIT_V
#undef PG8_WAIT_L
#undef PG8_BAR
#undef PG8_SCHED
#undef PG8_VOFFA
}

__device__ __forceinline__ bool static_tile(int nM, int nN, int G, int c, int i, int& pm, int& pn) {
    const int nwg = nM * nN; const long L = (long)i * G + c; if (L >= nwg) return false;
    int wgid = (int)L; { const int q = nwg / NXCD, r = nwg % NXCD, xcd = wgid % NXCD, off = wgid / NXCD; wgid = (xcd < r ? xcd * (q + 1) : r * (q + 1) + (xcd - r) * q) + off; }
    const int nig = WGM * nN, gid = wgid / nig, fm = gid * WGM, gsz = (nM - fm) < WGM ? (nM - fm) : WGM;
    pm = fm + ((wgid % nig) % gsz); pn = (wgid % nig) / gsz; return true;
}
}

struct SchedIn {
    struct U { int pm, pn; };
    const char* A; const char* B; int lda, ldb, nt, G, c;
    __device__ __forceinline__ bool next(int i, U& u) const { int j; const bool ok = pg8::static_tile(NP / 256, 14, G, c, i, u.pm, j); u.pn = (j < 6) ? 2 + j : 10 + j; return ok; }
    __device__ __forceinline__ int nt_u(const U&) const { return nt; }
    __device__ __forceinline__ const char* a_base(const U&) const { return A; }
    __device__ __forceinline__ unsigned a_row(const U& u, int r) const { return (unsigned)(u.pm * 256 + r); }
    __device__ __forceinline__ const char* b_base(const U& u) const { return B + (size_t)u.pn * 256 * ldb * 2; }
};
struct SchedIn8 {
    typedef SchedIn::U U;
    const char* A; const char* B; int lda, ldb, nt, G, c;
    __device__ __forceinline__ bool next(int i, U& u) const {
        if (i < 8) { const bool ok = pg8::static_tile(NS / 256, 32, G, c, i, u.pm, u.pn); u.pm += NP / 256; return ok; }
        int e; if (c < 224) { if (i > 8) return false; e = c; } else { if (i > 9) return false; e = 224 + 2 * (c - 224) + (i - 8); }
        if (e >= 288) return false;
        const int j = e >> 4; u.pm = e & 15; u.pn = (j < 2) ? j : (j < 10) ? 6 + j : 14 + j; return true; }
    __device__ __forceinline__ int nt_u(const U&) const { return nt; }
    __device__ __forceinline__ const char* a_base(const U&) const { return A; }
    __device__ __forceinline__ unsigned a_row(const U& u, int r) const { return (unsigned)(u.pm * 256 + r); }
    __device__ __forceinline__ const char* b_base(const U& u) const { return B + (size_t)u.pn * 256 * ldb; }
};
struct EpiIn {
    static constexpr bool HAS_MID = false;
    unsigned char* ws; float* out; const float* rope; float osc;
    __device__ __forceinline__ void operator()(const f32x4 (&acc)[2][2][4][2], const SchedIn::U& u, int wr, int wc, int fr, int fq) const {
        const int pn = u.pn; int kind, t0, width; size_t off;
        if (pn < 2) { kind = 0; t0 = 0; width = 512; off = WS_QA; } else if (pn < 4) { kind = 1; t0 = 2; width = 512; off = WS_KA; }
        else if (pn < 8) { kind = 1; t0 = 4; width = 1024; off = WS_VA; } else if (pn < 12) { kind = 2; t0 = 8; width = 1024; off = WS_RA; }
        else if (pn < 16) { kind = 3; t0 = 12; width = 1024; off = WS_QD; } else if (pn < 20) { kind = 4; t0 = 16; width = 1024; off = WS_KD; }
        else if (pn < 24) { kind = 5; t0 = 20; width = 1024; off = WS_VD; } else if (pn < 28) { kind = 6; t0 = 24; width = 1024; off = WS_GA; }
        else { kind = 6; t0 = 28; width = 1024; off = WS_GB; }
        bf16_t* base = (bf16_t*)(ws + off);
        const int row0 = u.pm * 256 + wr * 64 + fr, col0 = (pn - t0) * 256 + wc * 32 + 8 * fq;
        const bool prompt = u.pm < 16;
        const bool rope_on = (kind == 3 || kind == 4) && !prompt;
        const float sgn = (fq < 2) ? -1.f : 1.f;
#pragma unroll
        for (int ai = 0; ai < 2; ++ai)
#pragma unroll
            for (int m = 0; m < 4; ++m) {
                const int row = row0 + ai * 128 + m * 16;
                bf16_t* rowp = base + (size_t)row * width + col0;
                f32x4 cs0, cs1, sn0, sn1;
                if (rope_on) {
                    const int l = (row - NP) & 2047; const int pos = (wc & 1) ? (l & 63) : (l >> 6);
                    const float* tb = rope + ((wc & 1) ? 1024 : 0) + pos * 16 + 8 * (fq & 1);
                    const int so = (wc & 1) ? 1024 : 512;
                    cs0 = *(const f32x4*)tb; cs1 = *(const f32x4*)(tb + 4); sn0 = *(const f32x4*)(tb + so); sn1 = *(const f32x4*)(tb + so + 4);
                }
#pragma unroll
                for (int bj = 0; bj < 2; ++bj) {
                    f32x4 v0 = acc[ai][bj][m][0] * osc, v1 = acc[ai][bj][m][1] * osc;
                    if (kind == 0) { v0 = v0 * 0.08838834764831845f; v1 = v1 * 0.08838834764831845f; }
                    else if (kind == 2) {
#pragma unroll
                        for (int j = 0; j < 4; ++j) { v0[j] = siluf_(v0[j]); v1[j] = siluf_(v1[j]); } }
                    else if (kind == 6) {
#pragma unroll
                        for (int j = 0; j < 4; ++j) { v0[j] = sigmoidf_(v0[j]); v1[j] = sigmoidf_(v1[j]); } }
                    if ((kind == 4 || kind == 5) && prompt) {
                        float* o32 = out + (kind == 4 ? O_NK : O_NV) + (size_t)row * 1024 + col0 + bj * 128;
                        *(f32x4*)o32 = v0; *(f32x4*)(o32 + 4) = v1;
                    }
                    if (rope_on) {
                        f32x4 p0, p1;
#pragma unroll
                        for (int j = 0; j < 4; ++j) {
                            const auto ra = __builtin_amdgcn_permlane32_swap(__float_as_uint(v0[j]), __float_as_uint(v0[j]), false, false);
                            const auto rb = __builtin_amdgcn_permlane32_swap(__float_as_uint(v1[j]), __float_as_uint(v1[j]), false, false);
                            p0[j] = __uint_as_float(fq >= 2 ? ra[0] : ra[1]); p1[j] = __uint_as_float(fq >= 2 ? rb[0] : rb[1]); }
                        v0 = v0 * cs0 + p0 * sn0 * sgn; v1 = v1 * cs1 + p1 * sn1 * sgn;
                    }
                    u32x4 w; w.x = cvt_pk_bf16(v0[0], v0[1]); w.y = cvt_pk_bf16(v0[2], v0[3]); w.z = cvt_pk_bf16(v1[0], v1[1]); w.w = cvt_pk_bf16(v1[2], v1[3]);
                    *(u32x4*)(rowp + bj * 128) = w;
                }
            }
    }
};


namespace att {
constexpr float SCALE = 0.125f;
constexpr float THR = 8.f;
constexpr int SHM_V = 64 * 128 * 2, SHM_K = 64 * 128 * 2;
#define KSWZ(row, colB) ((row) * 256 + ((colB) ^ (((row) & 7) << 4)))
#define SBAR() __builtin_amdgcn_sched_barrier(0)
__device__ __forceinline__ int crow(int r, int hi) { return (r & 3) + 8 * (r >> 2) + 4 * hi; }
__device__ __forceinline__ void partialSM(f32x16& p0, f32x16& p1, float& m_reg, float& mn, float& alpha) {
  constexpr float C = SCALE * 1.4426950408889634f;
  float pmax = p0[0];
#pragma unroll
  for (int r = 1; r < 16; ++r) pmax = fmaxf(pmax, p0[r]);
#pragma unroll
  for (int r = 0; r < 16; ++r) pmax = fmaxf(pmax, p1[r]);
  { auto rr = __builtin_amdgcn_permlane32_swap(__float_as_uint(pmax), __float_as_uint(pmax), false, false);
    pmax = fmaxf(__uint_as_float(rr[0]), __uint_as_float(rr[1])); }
  if (__builtin_expect(__all(pmax - m_reg <= THR / SCALE), 1)) { mn = m_reg; alpha = 1.f; }
  else { mn = fmaxf(m_reg, pmax); alpha = __builtin_amdgcn_exp2f((m_reg - mn) * C); m_reg = mn; }
  const float mnC = -mn * C;
#pragma unroll
  for (int r = 0; r < 16; ++r) p0[r] = fmaf(p0[r], C, mnC);
#pragma unroll
  for (int r = 0; r < 16; ++r) p1[r] = fmaf(p1[r], C, mnC);
#pragma unroll
  for (int r = 0; r < 16; ++r) p0[r] = __builtin_amdgcn_exp2f(p0[r]);
}
__device__ __forceinline__ void finishSM(f32x16& p0, f32x16& p1, float alpha, float& l_reg, bf16x8& pa0, bf16x8& pa1, bf16x8& pa2, bf16x8& pa3) {
#pragma unroll
  for (int r = 0; r < 16; ++r) p1[r] = __builtin_amdgcn_exp2f(p1[r]);
  float ps = 0;
#pragma unroll
  for (int r = 0; r < 16; ++r) ps += p0[r];
#pragma unroll
  for (int r = 0; r < 16; ++r) ps += p1[r];
  { auto rr = __builtin_amdgcn_permlane32_swap(__float_as_uint(ps), __float_as_uint(ps), false, false);
    ps = __uint_as_float(rr[0]) + __uint_as_float(rr[1]); }
  l_reg = l_reg * alpha + ps;
#define PK4(P, BASE, OUT) do { unsigned a0 = cvt_pk_bf16(P[BASE + 0], P[BASE + 1]), a1 = cvt_pk_bf16(P[BASE + 2], P[BASE + 3]);   \
    unsigned b0 = cvt_pk_bf16(P[BASE + 4], P[BASE + 5]), b1 = cvt_pk_bf16(P[BASE + 6], P[BASE + 7]);                              \
    auto r0 = __builtin_amdgcn_permlane32_swap(a0, b0, false, false); auto r1 = __builtin_amdgcn_permlane32_swap(a1, b1, false, false); \
    u32x4 w = {r0[0], r1[0], r0[1], r1[1]}; OUT = __builtin_bit_cast(bf16x8, w); } while (0)
  PK4(p0, 0, pa0); PK4(p0, 8, pa1); PK4(p1, 0, pa2); PK4(p1, 8, pa3);
#undef PK4
}
__device__ __forceinline__ void qkt(f32x16& p0, f32x16& p1, const LAS char* Ks, const bf16x8* qr, int r32, int hi, int comp) {
#pragma unroll
  for (int r = 0; r < 16; ++r) { p0[r] = 0.f; p1[r] = 0.f; }
#pragma unroll
  for (int d0 = 0; d0 < 4; ++d0) { const int cb = (comp * 64 + d0 * 16 + hi * 8) * 2;
    const bf16x8 b0 = *(const LAS bf16x8*)(Ks + KSWZ(r32, cb));
    const bf16x8 b1 = *(const LAS bf16x8*)(Ks + KSWZ(32 + r32, cb));
    p0 = __builtin_amdgcn_mfma_f32_32x32x16_bf16(b0, qr[d0], p0, 0, 0, 0);
    p1 = __builtin_amdgcn_mfma_f32_32x32x16_bf16(b1, qr[d0], p1, 0, 0, 0); }
}
__device__ __forceinline__ int v_st(int k, int c) { const int kk = (k & ~0xC) | ((k & 4) << 1) | ((k & 8) >> 1); return ((kk >> 3) * 4 + (c >> 5)) * 512 + ((kk & 7) * 32 + (c & 31)) * 2; }
__device__ __forceinline__ int v_rd_base(int lane) { return ((lane & 3) << 3) | (((lane >> 2) & 3) << 6) | (((lane >> 4) & 1) << 5) | (((lane >> 5) & 1) << 8); }
constexpr int v_rd_off(int d0, int ks, int half) { return d0 * 512 + ks * 4096 + half * 2048; }
template <int OFF> __device__ __forceinline__ s16x4 tr_read(int vb) {
  s16x4 r; asm volatile("ds_read_b64_tr_b16 %0, %1 offset:%2" : "=&v"(r) : "v"(vb), "i"(OFF) : "memory"); return r;
}
template <int D0> __device__ __forceinline__ void pv_one(f32x16& od, int vb, bf16x8 pa0, bf16x8 pa1, bf16x8 pa2, bf16x8 pa3) {
  const s16x4 l0 = tr_read<v_rd_off(D0, 0, 0)>(vb), h0 = tr_read<v_rd_off(D0, 0, 1)>(vb), l1 = tr_read<v_rd_off(D0, 1, 0)>(vb), h1 = tr_read<v_rd_off(D0, 1, 1)>(vb);
  const s16x4 l2 = tr_read<v_rd_off(D0, 2, 0)>(vb), h2 = tr_read<v_rd_off(D0, 2, 1)>(vb), l3 = tr_read<v_rd_off(D0, 3, 0)>(vb), h3 = tr_read<v_rd_off(D0, 3, 1)>(vb);
  asm volatile("s_waitcnt lgkmcnt(0)" ::: "memory"); SBAR();
#define PK(L, H) (bf16x8){L[0], L[1], L[2], L[3], H[0], H[1], H[2], H[3]}
  od = __builtin_amdgcn_mfma_f32_32x32x16_bf16(pa0, PK(l0, h0), od, 0, 0, 0);
  od = __builtin_amdgcn_mfma_f32_32x32x16_bf16(pa1, PK(l1, h1), od, 0, 0, 0);
  od = __builtin_amdgcn_mfma_f32_32x32x16_bf16(pa2, PK(l2, h2), od, 0, 0, 0);
  od = __builtin_amdgcn_mfma_f32_32x32x16_bf16(pa3, PK(l3, h3), od, 0, 0, 0);
#undef PK
}
__device__ __forceinline__ void pv_d0(f32x16* o, int vb, bf16x8 pa0, bf16x8 pa1, bf16x8 pa2, bf16x8 pa3) {
  pv_one<0>(o[0], vb, pa0, pa1, pa2, pa3); pv_one<1>(o[1], vb, pa0, pa1, pa2, pa3); pv_one<2>(o[2], vb, pa0, pa1, pa2, pa3); pv_one<3>(o[3], vb, pa0, pa1, pa2, pa3);
}

struct Unit { const bf16_t* Q; const bf16_t* K0; const bf16_t* V0; const bf16_t* K1; const bf16_t* V1; unsigned char* O; int nt0, NT; };

__device__ __forceinline__ void unit_body(const Unit& U, LAS char* lds, float lam, const float* __restrict__ subg, const int tid) {
  constexpr int LD = 1024;
  const int wid = tid >> 6, lane = tid & 63, r32 = lane & 31, hi = lane >> 5, qs = wid >> 1, comp = wid & 1;
  LAS char* V_lds = lds; LAS char* K_lds = lds + 2 * SHM_V;
  LAS float* wsf = (LAS float*)(lds + 2 * SHM_V + 2 * SHM_K) + wid * 64; LAS float* li_l = wsf; LAS float* al_l = wsf + 32;
  float m_reg = -1e30f, l_reg = 0; f32x16 o[4]; bf16x8 qr[4];
#pragma unroll
  for (int d = 0; d < 4; ++d)
#pragma unroll
    for (int r = 0; r < 16; ++r) o[d][r] = 0.f;
  const bf16_t* Qw = U.Q + (size_t)(qs * 32 + r32) * LD + comp * 64 + hi * 8;
#pragma unroll
  for (int d0 = 0; d0 < 4; ++d0) qr[d0] = *(const bf16x8*)(Qw + d0 * 16);
  const int sr = tid >> 4, sc = (tid & 15) * 8, vst0 = v_st(sr, sc), vst1 = v_st(32 + sr, sc);
  const int vb0 = (int)(uintptr_t)V_lds + v_rd_base(lane);
  const unsigned so0 = (unsigned)(sr * LD + sc) * 2u, so1 = (unsigned)((32 + sr) * LD + sc) * 2u;
  struct { bf16x8 vs0, vs1, ks0, ks1; } sr_[2];
#define TILE_K(t) (((t) < U.nt0) ? U.K0 + (size_t)(t) * 64 * LD : U.K1 + (size_t)((t) - U.nt0) * 64 * LD)
#define TILE_V(t) (((t) < U.nt0) ? U.V0 + (size_t)(t) * 64 * LD : U.V1 + (size_t)((t) - U.nt0) * 64 * LD)
#define SLOAD(i, t) do { const char* _kb = (const char*)TILE_K(t); const char* _vb = (const char*)TILE_V(t); \
    sr_[i].vs0 = *(const bf16x8*)(_vb + so0); sr_[i].vs1 = *(const bf16x8*)(_vb + so1); \
    sr_[i].ks0 = *(const bf16x8*)(_kb + so0); sr_[i].ks1 = *(const bf16x8*)(_kb + so1); } while (0)
#define SWRITE(b, i) do { *(LAS bf16x8*)(V_lds + (b) * SHM_V + vst0) = sr_[i].vs0; *(LAS bf16x8*)(V_lds + (b) * SHM_V + vst1) = sr_[i].vs1; const int kc = sc * 2; \
    *(LAS bf16x8*)(K_lds + (b) * SHM_K + KSWZ(sr, kc)) = sr_[i].ks0; *(LAS bf16x8*)(K_lds + (b) * SHM_K + KSWZ(32 + sr, kc)) = sr_[i].ks1; } while (0)
#define SWAIT() asm volatile("s_waitcnt vmcnt(4)" ::: "memory")
#define RESC(a) do { if (__any((a) < 1.f)) { if (hi == 0) al_l[r32] = (a); asm volatile("s_waitcnt lgkmcnt(0)" ::: "memory"); \
    _Pragma("unroll") for (int d = 0; d < 4; ++d) _Pragma("unroll") for (int r = 0; r < 16; ++r) o[d][r] *= al_l[crow(r, hi)]; } } while (0)
  f32x16 pA0, pA1, pB0, pB1; float mnA, mnB, alA, alB; bf16x8 pa0, pa1, pa2, pa3; const int NT = U.NT;
  constexpr int SE = 0, SO = 1;
  SLOAD(SE, 0); asm volatile("s_waitcnt vmcnt(0)" ::: "memory"); SWRITE(0, SE); __syncthreads();
  qkt(pA0, pA1, K_lds, qr, r32, hi, comp); partialSM(pA0, pA1, m_reg, mnA, alA);
  SLOAD(SO, 1); if (2 < NT) SLOAD(SE, 2);
  SWAIT(); SWRITE(1, SO); __syncthreads();
  for (int j = 1; j + 1 < NT; j += 2) {
    SBAR(); qkt(pB0, pB1, K_lds + SHM_K, qr, r32, hi, comp);
    finishSM(pA0, pA1, alA, l_reg, pa0, pa1, pa2, pa3); SBAR();
    SLOAD(SO, j + 2); SBAR();
    pv_d0(o, vb0, pa0, pa1, pa2, pa3); partialSM(pB0, pB1, m_reg, mnB, alB);
    __syncthreads(); SWAIT(); SWRITE(0, SE);
    RESC(alB); __syncthreads();
    SBAR(); qkt(pA0, pA1, K_lds, qr, r32, hi, comp);
    finishSM(pB0, pB1, alB, l_reg, pa0, pa1, pa2, pa3); SBAR();
    if (j + 3 < NT) SLOAD(SE, j + 3); SBAR();
    pv_d0(o, vb0 + SHM_V, pa0, pa1, pa2, pa3); partialSM(pA0, pA1, m_reg, mnA, alA);
    __syncthreads(); SWAIT(); SWRITE(1, SO);
    RESC(alA); __syncthreads();
  }
  SBAR(); qkt(pB0, pB1, K_lds + SHM_K, qr, r32, hi, comp);
  finishSM(pA0, pA1, alA, l_reg, pa0, pa1, pa2, pa3); SBAR();
  pv_d0(o, vb0, pa0, pa1, pa2, pa3); partialSM(pB0, pB1, m_reg, mnB, alB);
  __syncthreads(); RESC(alB);
  finishSM(pB0, pB1, alB, l_reg, pa0, pa1, pa2, pa3); SBAR();
  pv_d0(o, vb0 + SHM_V, pa0, pa1, pa2, pa3);
  if (hi == 0) li_l[r32] = l_reg; asm volatile("s_waitcnt lgkmcnt(0)" ::: "memory");
  int lane_e = lane; asm volatile("" : "+v"(lane_e));
#define lane lane_e
#define r32 (lane_e & 31)
#define hi (lane_e >> 5)
  float rli[16];
#pragma unroll
  for (int r = 0; r < 16; ++r) rli[r] = 1.0f / li_l[crow(r, hi)];
  __syncthreads();
  LAS float* X = (LAS float*)lds + qs * 4096;
  if (comp == 1) {
#pragma unroll
    for (int d = 0; d < 4; ++d)
#pragma unroll
      for (int r = 0; r < 16; ++r) X[(d * 16 + r) * 64 + lane] = o[d][r] * rli[r] * lam;
  }
  __syncthreads();
  if (comp == 0) {
    float ss[16];
#pragma unroll
    for (int r = 0; r < 16; ++r) ss[r] = 0.f;
#pragma unroll
    for (int d = 0; d < 4; ++d)
#pragma unroll
      for (int r = 0; r < 16; ++r) { o[d][r] = o[d][r] * rli[r] - X[(d * 16 + r) * 64 + lane]; ss[r] += o[d][r] * o[d][r]; }
#pragma unroll
    for (int r = 0; r < 16; ++r) {
#pragma unroll
      for (int of = 1; of < 32; of <<= 1) ss[r] += __shfl_xor(ss[r], of);
      ss[r] = 0.8f / sqrtf(ss[r] * (1.f / 128.f) + LN_EPS);
    }
    LAS unsigned char* OT = (LAS unsigned char*)lds + 73728;
    float gg[4];
#pragma unroll
    for (int d = 0; d < 4; ++d) gg[d] = subg[d * 32 + r32];
#pragma unroll
    for (int r = 0; r < 16; ++r)
      *(LAS unsigned*)(OT + (qs * 32 + crow(r, hi)) * 128 + r32 * 4) = pk4_fp8(o[0][r] * ss[r] * gg[0], o[1][r] * ss[r] * gg[1], o[2][r] * ss[r] * gg[2], o[3][r] * ss[r] * gg[3]);
  }
  __syncthreads();
#undef lane
#undef r32
#undef hi
  int t2 = tid; asm volatile("" : "+v"(t2));
#pragma unroll
  for (int i = 0; i < 2; ++i) { const int idx = t2 + 512 * i, row = idx >> 3, c16 = idx & 7;
    *(u32x4*)(U.O + (size_t)row * 2048 + c16 * 16) = *(const LAS u32x4*)((LAS unsigned char*)lds + 73728 + row * 128 + c16 * 16); }
  __syncthreads();
#undef TILE_K
#undef TILE_V
#undef SLOAD
#undef SWRITE
#undef SWAIT
#undef RESC
}
}

namespace gla {
constexpr int G_QE = 0, G_KE = 17408, G_KDT = 34816, G_VT = 53248, G_AF = 90112, G_TOT = 94208, G_EBL = 96256, G_WA = 96768, G_VR = 105472;
__device__ __forceinline__ int crow(int r, int hi) { return (r & 3) + 8 * (r >> 2) + 4 * hi; }
__device__ __forceinline__ int qe_addr(int row, int pos) { return row * 272 + pos * 2; }
__device__ __forceinline__ int t_addr(int row, int chunk) { return row * 144 + chunk * 16; }
__device__ __forceinline__ constexpr int swz23(int x) { return (x & ~12) | ((x & 4) << 1) | ((x & 8) >> 1); }
__device__ __forceinline__ bf16x8 pack8(const f32x16& x, int s) {
  u32x4 p; p.x = cvt_pk_bf16(x[8 * s], x[8 * s + 1]); p.y = cvt_pk_bf16(x[8 * s + 2], x[8 * s + 3]); p.z = cvt_pk_bf16(x[8 * s + 4], x[8 * s + 5]); p.w = cvt_pk_bf16(x[8 * s + 6], x[8 * s + 7]);
  return __builtin_bit_cast(bf16x8, p);
}
#define GMFMA(a, b, c) __builtin_amdgcn_mfma_f32_32x32x16_bf16((a), (b), (c), 0, 0, 0)

__device__ __forceinline__ void chain(const Params& P, LAS char* lds, int chain_id, const int tid_in) {
  int tid = tid_in; asm volatile("" : "+v"(tid));
  const bool samp = chain_id < 64; const int cc = samp ? chain_id : chain_id - 64;
  const int b = cc >> 3, h = (cc >> 1) & 3, dir = cc & 1;
  const int L = samp ? SEQ_S : SEQ_P, nchunk = L / 64, tok0 = samp ? NP + b * SEQ_S : b * SEQ_P;
  const int w = tid >> 6, lane = tid & 63, r32 = lane & 31, hi = lane >> 5;
  const int dk = tid & 127, tg = tid >> 7, dv = tid & 255, th = tid >> 8;
  const bf16_t* QA = (const bf16_t*)(P.ws + WS_QA); const bf16_t* KA = (const bf16_t*)(P.ws + WS_KA); const bf16_t* VA = (const bf16_t*)(P.ws + WS_VA);
  const float* AFAB = (const float*)(P.ws + WS_AFAB);
  bf16_t* OUT = (bf16_t*)(P.ws + (dir ? WS_OB : WS_OF));
  const float* wal = dir ? P.in[I_WAB] : P.in[I_WAF]; const float* bal = dir ? P.in[I_BAB] : P.in[I_BAF];
  LAS float* wal_l = (LAS float*)(lds + G_WA);
  for (int i = tid; i < 17 * 128; i += NTHREADS) wal_l[i] = (i < 2048) ? wal[(i >> 7) * 512 + h * 128 + (i & 127)] : bal[h * 128 + (i & 127)];
  f32x16 St[4];
  if (samp) { const float* s0 = (dir ? P.in[I_SB] : P.in[I_SF]) + (size_t)(b * 4 + h) * 128 * 256;
#pragma unroll
    for (int kb = 0; kb < 4; ++kb)
#pragma unroll
      for (int r = 0; r < 16; ++r) St[kb][r] = s0[(size_t)(32 * kb + crow(r, hi)) * 256 + 32 * w + r32];
  } else {
#pragma unroll
    for (int kb = 0; kb < 4; ++kb)
#pragma unroll
      for (int r = 0; r < 16; ++r) St[kb][r] = 0.f;
  }
  LAS float* afl = (LAS float*)(lds + G_AF); LAS float* tot = (LAS float*)(lds + G_TOT); LAS float* ebl = (LAS float*)(lds + G_EBL);
#define TOKC(c_, i) (tok0 + (dir ? (L - 1 - (64 * (c_) + (i))) : (64 * (c_) + (i))))
  f32x4 saf = {0.f, 0.f, 0.f, 0.f}; u32x4 sq[2], sk[2], sv[4];
#define GLA_LOAD(CH) do { int t_ = tid; asm volatile("" : "+v"(t_)); \
    if (t_ < 256) { const int i = t_ >> 2, q = t_ & 3; saf = *(const f32x4*)(AFAB + (size_t)TOKC(CH, i) * 32 + dir * 16 + 4 * q); } \
    _Pragma("unroll") for (int n = 0; n < 2; ++n) { const int c = t_ + 512 * n, i = c >> 4, d0 = (c & 15) * 8; const size_t t = (size_t)TOKC(CH, i); \
      sq[n] = *(const u32x4*)(QA + t * 512 + h * 128 + d0); sk[n] = *(const u32x4*)(KA + t * 512 + h * 128 + d0); } \
    _Pragma("unroll") for (int n = 0; n < 4; ++n) { const int c = t_ + 512 * n, i = c >> 5, cq = c & 31; sv[n] = *(const u32x4*)(VA + (size_t)TOKC(CH, i) * 1024 + h * 256 + cq * 8); } } while (0)
  GLA_LOAD(0);
  for (int ch = 0; ch < nchunk; ++ch) {
#define TOK(i) TOKC(ch, i)
    int tp_ = tid; asm volatile("" : "+v"(tp_));
    const int dk = tp_ & 127, tg = tp_ >> 7, dv = tp_ & 255, th = tp_ >> 8;
    if (tp_ < 256) *((LAS f32x4*)afl + tp_) = saf;
#pragma unroll
    for (int n = 0; n < 2; ++n) { const int c = tp_ + 512 * n, i = c >> 4, d0 = (c & 15) * 8;
      const u32x4 xq = sq[n], xk = sk[n];
      const int p0 = swz23(d0 & 15) | (d0 & ~15), p1 = swz23((d0 + 4) & 15) | (d0 & ~15);
      *(LAS u32x2*)(lds + G_QE + qe_addr(i, p0)) = (u32x2){xq.x, xq.y}; *(LAS u32x2*)(lds + G_QE + qe_addr(i, p1)) = (u32x2){xq.z, xq.w};
      *(LAS u32x2*)(lds + G_KE + qe_addr(i, p0)) = (u32x2){xk.x, xk.y}; *(LAS u32x2*)(lds + G_KE + qe_addr(i, p1)) = (u32x2){xk.z, xk.w}; }
#pragma unroll
    for (int n = 0; n < 4; ++n) { const int c = tp_ + 512 * n, i = c >> 5, cq = c & 31;
      *(LAS u32x4*)(lds + G_VR + i * 528 + cq * 16) = sv[n]; }
    __syncthreads();
    float bl[16]; float run = 0.f;
    float wa[16];
#pragma unroll
    for (int r = 0; r < 16; ++r) wa[r] = wal_l[r * 128 + dk];
    const float ba = wal_l[2048 + dk];
#pragma unroll
    for (int ii = 0; ii < 16; ++ii) { const int i = 16 * tg + ii; float z = ba;
#pragma unroll
      for (int q = 0; q < 4; ++q) { const f32x4 a = *((const LAS f32x4*)afl + i * 4 + q); z += a.x * wa[4 * q] + a.y * wa[4 * q + 1] + a.z * wa[4 * q + 2] + a.w * wa[4 * q + 3]; }
      const float g = (fminf(z, 0.f) - __logf(1.0f + __expf(-fabsf(z)))) * (1.0f / 16.0f);
      run += g; bl[ii] = run; }
    tot[tg * 128 + dk] = run;
#pragma unroll
    for (int q = 0; q < 4; ++q) { const int b16 = (q >> 1) * 16, q8 = (q & 1) * 8; unsigned short e[8];
#pragma unroll
      for (int j = 0; j < 8; ++j) e[j] = *(const LAS unsigned short*)(lds + G_VR + (32 * th + b16 + swz23(q8 + j)) * 528 + dv * 2);
      u32x4 o; o.x = (unsigned)e[0] | ((unsigned)e[1] << 16); o.y = (unsigned)e[2] | ((unsigned)e[3] << 16); o.z = (unsigned)e[4] | ((unsigned)e[5] << 16); o.w = (unsigned)e[6] | ((unsigned)e[7] << 16);
      *(LAS u32x4*)(lds + G_VT + t_addr(dv, 4 * th + q)) = o; }
    __syncthreads();
    if (ch + 1 < nchunk) GLA_LOAD(ch + 1);
    const float t0 = tot[dk], t1 = tot[128 + dk], t2 = tot[256 + dk], t3 = tot[384 + dk];
    const float pre = (tg > 0 ? t0 : 0.f) + (tg > 1 ? t1 : 0.f) + (tg > 2 ? t2 : 0.f), total = (t0 + t1) + (t2 + t3);
    const float etot = __expf(total);
    if (tg == 0) ebl[dk] = etot;
    const int pdk = swz23(dk & 15) | (dk & ~15);
    unsigned short kdv[16];
#pragma unroll
    for (int ii = 0; ii < 16; ++ii) { const int i = 16 * tg + ii; const float bc = pre + bl[ii];
      LAS unsigned short* qp = (LAS unsigned short*)(lds + G_QE + qe_addr(i, pdk)); LAS unsigned short* kp = (LAS unsigned short*)(lds + G_KE + qe_addr(i, pdk));
      const float q = bf2f(*qp), k = bf2f(*kp);
      const float eb = __expf(bc), ieb = __builtin_amdgcn_rcpf(eb);
      const unsigned pq = cvt_pk_bf16(q * eb, k * ieb);
      *qp = (unsigned short)(pq & 0xffffu); *kp = (unsigned short)(pq >> 16);
      kdv[ii] = (unsigned short)(cvt_pk_bf16(k * (etot * ieb), 0.f) & 0xffffu); }
#pragma unroll
    for (int q = 0; q < 2; ++q) { u32x4 o;
      o.x = (unsigned)kdv[swz23(8 * q + 0)] | ((unsigned)kdv[swz23(8 * q + 1)] << 16); o.y = (unsigned)kdv[swz23(8 * q + 2)] | ((unsigned)kdv[swz23(8 * q + 3)] << 16);
      o.z = (unsigned)kdv[swz23(8 * q + 4)] | ((unsigned)kdv[swz23(8 * q + 5)] << 16); o.w = (unsigned)kdv[swz23(8 * q + 6)] | ((unsigned)kdv[swz23(8 * q + 7)] << 16);
      *(LAS u32x4*)(lds + G_KDT + t_addr(dk, 2 * tg + q)) = o; }
    __syncthreads();
    int tm_ = tid; asm volatile("" : "+v"(tm_));
    const int w = tm_ >> 6, lane = tm_ & 63, r32 = lane & 31, hi = lane >> 5;
    bf16x8 Sb[4][2];
#pragma unroll
    for (int kb = 0; kb < 4; ++kb) { Sb[kb][0] = pack8(St[kb], 0); Sb[kb][1] = pack8(St[kb], 1); }
    f32x16 o[2];
#pragma unroll
    for (int ib = 0; ib < 2; ++ib) {
#pragma unroll
      for (int r = 0; r < 16; ++r) o[ib][r] = 0.f;
#pragma unroll
      for (int kb = 0; kb < 4; ++kb)
#pragma unroll
        for (int s = 0; s < 2; ++s) { const bf16x8 a = *(const LAS bf16x8*)(lds + G_QE + qe_addr(32 * ib + r32, 32 * kb + 16 * s + 8 * hi)); o[ib] = GMFMA(a, Sb[kb][s], o[ib]); }
      asm volatile("" ::: "memory");
    }
    bf16x8 vf[2][2];
#pragma unroll
    for (int jb = 0; jb < 2; ++jb)
#pragma unroll
      for (int s = 0; s < 2; ++s) vf[jb][s] = *(const LAS bf16x8*)(lds + G_VT + t_addr(32 * w + r32, 4 * jb + 2 * s + hi));
#pragma unroll
    for (int blk = 0; blk < 3; ++blk) { const int jb = (blk == 2) ? 1 : 0, ib = (blk == 0) ? 0 : 1;
      f32x16 X;
#pragma unroll
      for (int r = 0; r < 16; ++r) X[r] = 0.f;
#pragma unroll
      for (int ks = 0; ks < 8; ++ks) { const bf16x8 a = *(const LAS bf16x8*)(lds + G_KE + qe_addr(32 * jb + r32, 16 * ks + 8 * hi));
        const bf16x8 bq = *(const LAS bf16x8*)(lds + G_QE + qe_addr(32 * ib + r32, 16 * ks + 8 * hi)); X = GMFMA(a, bq, X); }
      if (jb == ib) {
#pragma unroll
        for (int r = 0; r < 16; ++r) X[r] = (r32 >= crow(r, hi)) ? X[r] : 0.f; }
#pragma unroll
      for (int s = 0; s < 2; ++s) { const bf16x8 xa = pack8(X, s); o[ib] = GMFMA(xa, vf[jb][s], o[ib]); }
      asm volatile("" ::: "memory");
    }
#pragma unroll
    for (int kb = 0; kb < 4; ++kb) {
#pragma unroll
      for (int g = 0; g < 4; ++g) { const f32x4 e4 = *(const LAS f32x4*)(ebl + 32 * kb + 8 * g + 4 * hi);
        St[kb][4 * g] *= e4.x; St[kb][4 * g + 1] *= e4.y; St[kb][4 * g + 2] *= e4.z; St[kb][4 * g + 3] *= e4.w; }
#pragma unroll
      for (int jb = 0; jb < 2; ++jb)
#pragma unroll
        for (int s = 0; s < 2; ++s) { const bf16x8 a = *(const LAS bf16x8*)(lds + G_KDT + t_addr(32 * kb + r32, 4 * jb + 2 * s + hi)); St[kb] = GMFMA(a, vf[jb][s], St[kb]); }
      asm volatile("" ::: "memory");
    }
#pragma unroll
    for (int ib = 0; ib < 2; ++ib)
#pragma unroll
      for (int r = 0; r < 16; ++r) *(LAS unsigned short*)(lds + G_VR + (32 * ib + crow(r, hi)) * 528 + (32 * w + r32) * 2) = (unsigned short)(cvt_pk_bf16(o[ib][r], 0.f) & 0xffffu);
    __syncthreads();
    { int t2 = tid; asm volatile("" : "+v"(t2));
#pragma unroll
      for (int n = 0; n < 4; ++n) { const int c = t2 + 512 * n, i = c >> 5, cq = c & 31;
        *(u32x4*)(OUT + (size_t)TOK(i) * 1024 + h * 256 + cq * 8) = *(const LAS u32x4*)(lds + G_VR + i * 528 + cq * 16); } }
    __syncthreads();
#undef TOK
  }
#undef GLA_LOAD
#undef TOKC
  asm volatile("s_waitcnt vmcnt(0)" ::: "memory"); __syncthreads();
  if (tid == 0) { __builtin_amdgcn_fence(__ATOMIC_RELEASE, "agent"); asm volatile("s_waitcnt vmcnt(0)" ::: "memory");
    __hip_atomic_fetch_add((unsigned*)(P.ws + WS_CTL) + 512 + 16 * (samp ? 16 + b : b), 1u, __ATOMIC_RELAXED, __HIP_MEMORY_SCOPE_AGENT); }
  if (!samp) { float* so = P.out + (dir ? O_NB : O_NF) + (size_t)(b * 4 + h) * 128 * 256;
#pragma unroll
    for (int kb = 0; kb < 4; ++kb)
#pragma unroll
      for (int r = 0; r < 16; ++r) so[(size_t)(32 * kb + crow(r, hi)) * 256 + 32 * w + r32] = St[kb][r]; }
}
}

__device__ __forceinline__ void p4_item(Frame& F, int item) {
    const Params& P = *F.p;
    int tl_ = F.tid; asm volatile("" : "+v"(tl_)); const int p4lane = tl_ & 63, p4wave = tl_ >> 6;
    const bf16_t* OFp = (const bf16_t*)(P.ws + WS_OF); const bf16_t* OBp = (const bf16_t*)(P.ws + WS_OB); const bf16_t* RA = (const bf16_t*)(P.ws + WS_RA);
    bf16_t* OAN = (bf16_t*)(P.ws + WS_OCAT);
    const f32x4 g = *((const f32x4*)P.in[I_GLAG] + p4lane);
#pragma unroll 2
    for (int t = 0; t < 8; ++t) {
        const int m = item * 64 + t * 8 + p4wave;
        const size_t rb = (size_t)m * 1024 + 4 * p4lane;
        u32x2 a[4], b[4], r[4];
#pragma unroll
        for (int j = 0; j < 4; ++j) { a[j] = *(const u32x2*)(OFp + rb + 256 * j); b[j] = *(const u32x2*)(OBp + rb + 256 * j); r[j] = *(const u32x2*)(RA + rb + 256 * j); }
#pragma unroll
        for (int j = 0; j < 4; ++j) {
            f32x4 f; f.x = bflo(a[j].x) + bflo(b[j].x); f.y = bfhi(a[j].x) + bfhi(b[j].x); f.z = bflo(a[j].y) + bflo(b[j].y); f.w = bfhi(a[j].y) + bfhi(b[j].y);
            const float ss = wave_sum((f.x * f.x + f.y * f.y) + (f.z * f.z + f.w * f.w));
            const float rs = 1.f / sqrtf(ss * (1.f / 256.f) + LN_EPS);
            *(unsigned*)((unsigned char*)OAN + (size_t)m * 2048 + 4 * p4lane + 256 * j) = pk4_fp8(f.x * rs * g.x * bflo(r[j].x), f.y * rs * g.y * bfhi(r[j].x), f.z * rs * g.z * bflo(r[j].y), f.w * rs * g.w * bfhi(r[j].y));
        }
    }
}

constexpr int Q_GLA = 192, Q_AS = 1024, Q_AP = 256, CONV_PER = 28, CONV_P3 = (Q_AS / 8) * CONV_PER, Q_AS_EXT = Q_AS + Q_AS / 8, Q_ATT = Q_AS_EXT + Q_AP;
static_assert(CONV_P3 <= CONV_TOTAL && (CONV_TOTAL - CONV_P3) % 4 == 0, "conversion split");
__device__ __forceinline__ void p3_mixers(Frame& F, int rep) {
    const Params& P = *F.p;
    unsigned* ctr = (unsigned*)(P.ws + WS_CTL) + rep;
    LAS unsigned* slot = (LAS unsigned*)(F.lds + LDS_BYTES - 64);
#define CONV_BATCH(N) do { const int _n = (N); if (_n > 0) { if (F.tid == 0) *slot = atomicAdd(ctr + 192, (unsigned)_n); __syncthreads(); const int _b = (int)*slot; __syncthreads(); \
        conv_batch(P, F.lds, F.tid, _b, _n); } } while (0)
#define samp_chain_batch(u) (((u) < 64) ? 12 : 2)
    const float lam = ((const float*)(P.ws + WS_MOD))[9 * 6144];
    const bf16_t* QD = (const bf16_t*)(P.ws + WS_QD); const bf16_t* KD = (const bf16_t*)(P.ws + WS_KD); const bf16_t* VD = (const bf16_t*)(P.ws + WS_VD);
    const bf16_t* CK = (const bf16_t*)(P.ws + WS_CK); const bf16_t* CV = (const bf16_t*)(P.ws + WS_CV); unsigned char* ODN = (unsigned char*)(P.ws + WS_OCAT) + 1024;
    for (int pass = 0; pass < 2; ++pass) {
    for (;;) {
        if (F.tid == 0) *slot = atomicAdd(ctr + 2 * pass, 1u);
        __syncthreads();
        const int u = (int)*slot;
        __syncthreads();
        if (u >= (pass ? Q_GLA - 64 : 64)) break;
        gla::chain(P, (LAS char*)F.lds, pass ? 64 + u : u, F.tid);
    }
    for (;;) {
        if (F.tid == 0) *slot = atomicAdd(ctr + 64 + 2 * pass, 1u);
        __syncthreads();
        int u = (int)*slot;
        __syncthreads();
        if (u >= (pass ? Q_AP : Q_AS_EXT)) break;
        if (pass) u += Q_AS_EXT;
        if (u < Q_AS_EXT) {
            if (u < 128 * 7) { const int g7 = u / 7, r7 = u - 7 * g7;
                if (r7 == 0) { conv_batch(P, F.lds, F.tid, g7 * CONV_PER, CONV_PER); continue; }
                u = 6 * g7 + r7 - 1; }
            else u -= 128; }
        else u = u - Q_AS_EXT + Q_AS;
        att::Unit U;
        if (u < Q_AS) {
            const int b = u >> 7, h = (u >> 4) & 7, qb = u & 15; const size_t tok0 = NP + (size_t)b * SEQ_S;
            U.Q = QD + (tok0 + qb * 128) * 1024 + h * 128; U.K0 = KD + tok0 * 1024 + h * 128; U.V0 = VD + tok0 * 1024 + h * 128;
            U.K1 = CK + (size_t)b * PAST * 1024 + h * 128; U.V1 = CV + (size_t)b * PAST * 1024 + h * 128; U.O = ODN + (tok0 + qb * 128) * 2048 + h * 128; U.nt0 = 32; U.NT = 36;
        } else {
            const int a = u - Q_AS, b = a >> 4, h = (a >> 1) & 7, qb = a & 1; const size_t tok0 = (size_t)b * SEQ_P;
            U.Q = QD + (tok0 + qb * 128) * 1024 + h * 128; U.K0 = KD + tok0 * 1024 + h * 128; U.V0 = VD + tok0 * 1024 + h * 128;
            U.K1 = U.K0; U.V1 = U.V0; U.O = ODN + (tok0 + qb * 128) * 2048 + h * 128; U.nt0 = 4; U.NT = 4;
        }
        att::unit_body(U, (LAS char*)F.lds, lam, P.in[I_SUBG], F.tid);
    }
    }
    for (;;) {
        if (F.tid == 0) *slot = atomicAdd(ctr + 128, 1u);
        __syncthreads();
        int it = (int)*slot;
        __syncthreads();
        if (it >= NTOK / 64) break;
        it = (it < 256) ? it + 64 : it - 256;
        const int bidx = (it < 64) ? (it >> 2) : 16 + ((it - 64) >> 5);
        if (F.tid == 0) {
            unsigned* c = (unsigned*)(P.ws + WS_CTL) + 512 + 16 * bidx; unsigned spins = 0;
            while (__hip_atomic_load(c, __ATOMIC_RELAXED, __HIP_MEMORY_SCOPE_AGENT) < 8u) { __builtin_amdgcn_s_sleep(8); if (++spins > (1u << 24)) break; }
            __builtin_amdgcn_fence(__ATOMIC_ACQUIRE, "agent"); asm volatile("s_waitcnt vmcnt(0)" ::: "memory");
        }
        __syncthreads();
        p4_item(F, it);
    }
#undef CONV_BATCH
#undef samp_chain_batch
}

struct SchedMrg {
    struct U { int pm, pn, half; };
    const char* A; const char* B; int lda, ldb, nt, G, c;
    __device__ __forceinline__ bool next(int i, U& u) const { const int L = c + G * i; if (L >= 384) return false;
        if (L < 256) { u.pm = L >> 2; u.pn = L & 3; u.half = -1; } else { const int s = L - 256, tl = 256 + (s >> 1); u.pm = tl >> 2; u.pn = tl & 3; u.half = s & 1; } return true; }
    __device__ __forceinline__ int nt_u(const U& u) const { return (u.half < 0) ? nt : nt / 2; }
    __device__ __forceinline__ const char* a_base(const U& u) const { return A + ((u.half == 1) ? 1024 : 0); }
    __device__ __forceinline__ unsigned a_row(const U& u, int r) const { return (unsigned)(u.pm * 256 + r); }
    __device__ __forceinline__ const char* b_base(const U& u) const { return B + (size_t)u.pn * 256 * ldb + ((u.half == 1) ? 1024 : 0); }
};
struct EpiMrg {
    static constexpr bool HAS_MID = true; static constexpr int MID_T = 8;
    const bf16_t* GA; const bf16_t* GB; bf16_t* M; unsigned char* WSB;
    __device__ __forceinline__ void mid(f32x4 (&acc)[2][2][4][2], const SchedMrg::U& u, int wr, int wc, int fr, int fq) const {
        asm volatile("" : "+v"(fr), "+v"(fq));
        const int row0 = u.pm * 256 + wr * 64 + fr, col0 = u.pn * 256 + wc * 32 + 8 * fq;
#pragma unroll
        for (int ai = 0; ai < 2; ++ai)
#pragma unroll
            for (int m = 0; m < 4; ++m) {
#pragma unroll
                for (int bj = 0; bj < 2; ++bj) {
                    const size_t off = (size_t)(row0 + ai * 128 + m * 16) * 1024 + col0 + bj * 128;
                    const u32x4 a = *(const u32x4*)(GA + off), b = *(const u32x4*)(GB + off);
#define RC(x) __builtin_amdgcn_rcpf(fmaxf((x), 1e-20f))
                    const f32x4 r0 = {bflo(a.x) * RC(bflo(b.x)), bfhi(a.x) * RC(bfhi(b.x)), bflo(a.y) * RC(bflo(b.y)), bfhi(a.y) * RC(bfhi(b.y))};
                    const f32x4 r1 = {bflo(a.z) * RC(bflo(b.z)), bfhi(a.z) * RC(bfhi(b.z)), bflo(a.w) * RC(bflo(b.w)), bfhi(a.w) * RC(bfhi(b.w))};
#undef RC
                    acc[ai][bj][m][0] = acc[ai][bj][m][0] * r0; acc[ai][bj][m][1] = acc[ai][bj][m][1] * r1;
                }
                asm volatile("" ::: "memory");
            }
    }
    __device__ __forceinline__ void operator()(const f32x4 (&acc)[2][2][4][2], const SchedMrg::U& u, int wr, int wc, int fr, int fq) const {
        const int row0 = u.pm * 256 + wr * 64 + fr, col0 = u.pn * 256 + wc * 32 + 8 * fq;
        const size_t goff = (u.half == 0) ? 0 : (size_t)(GB - GA);
        const size_t obase = (u.half < 0) ? WS_MRG : WS_MRG2 + (size_t)u.half * 1024 - (size_t)ROW_LO * 2048; const size_t old = (u.half < 0) ? 1024 : 2048;
#pragma unroll
        for (int ai = 0; ai < 2; ++ai)
#pragma unroll
            for (int m = 0; m < 4; ++m)
#pragma unroll
                for (int bj = 0; bj < 2; ++bj) {
                    const int row = row0 + ai * 128 + m * 16, col = col0 + bj * 128;
                    const size_t off = (size_t)row * 1024 + col;
                    const u32x4 g = *(const u32x4*)(GA + goff + off);
                    const f32x4 t0 = acc[ai][bj][m][0] * (f32x4){bflo(g.x), bfhi(g.x), bflo(g.y), bfhi(g.y)}, t1 = acc[ai][bj][m][1] * (f32x4){bflo(g.z), bfhi(g.z), bflo(g.w), bfhi(g.w)};
                    u32x2 w; w.x = pk4_fp8(t0.x * (S_MRG / S_WP), t0.y * (S_MRG / S_WP), t0.z * (S_MRG / S_WP), t0.w * (S_MRG / S_WP)); w.y = pk4_fp8(t1.x * (S_MRG / S_WP), t1.y * (S_MRG / S_WP), t1.z * (S_MRG / S_WP), t1.w * (S_MRG / S_WP));
                    *(u32x2*)(WSB + obase + (size_t)row * old + col) = w;
                    asm volatile("" ::: "memory");
                }
    }
};

struct SchedOut {
    struct U { int pm, pn, q; };
    const char* W; const char* B; int lda, ldb, nt, G, c;
    __device__ __forceinline__ bool next(int i, U& u) const { const int L = c + G * i; if (L >= 512) return false;
        if (L < 256) { u.pm = L >> 2; u.pn = L & 3; u.q = -1; } else { const int s = L - 256, tl = 256 + (s >> 2); u.pm = tl >> 2; u.pn = tl & 3; u.q = s & 3; } return true; }
    __device__ __forceinline__ int nt_u(const U& u) const { return (u.q < 0) ? nt : nt / 2; }
    __device__ __forceinline__ const char* a_base(const U& u) const { return W + ((u.q < 0) ? WS_MRG : WS_MRG2 + (size_t)u.q * 512); }
    __device__ __forceinline__ unsigned a_row(const U& u, int r) const { return (u.q < 0) ? (unsigned)(u.pm * 256 + r) : 2u * (unsigned)(u.pm * 256 - ROW_LO + r); }
    __device__ __forceinline__ const char* b_base(const U& u) const { return B + (size_t)u.pn * 256 * ldb + ((u.q < 0) ? 0 : u.q * 512); }
};
constexpr float ALPHA = 1.189207115002721f;
struct EpiOut {
    static constexpr bool HAS_MID = false;
    bf16_t* MIX; bf16_t* MIX2;
    __device__ __forceinline__ void operator()(const f32x4 (&acc)[2][2][4][2], const SchedOut::U& u, int wr, int wc, int fr, int fq) const {
        const int row0 = u.pm * 256 + wr * 64 + fr, col0 = u.pn * 256 + wc * 32 + 8 * fq;
        unsigned char* M8 = (unsigned char*)MIX;
        const size_t pbase = (u.q <= 0) ? 0 : (size_t)((unsigned char*)MIX2 - (unsigned char*)MIX) + ((size_t)(u.q - 1) * 4096 - ROW_LO) * 1024;
#pragma unroll
        for (int ai = 0; ai < 2; ++ai)
#pragma unroll
            for (int m = 0; m < 4; ++m)
#pragma unroll
                for (int bj = 0; bj < 2; ++bj) { const f32x4 v0 = acc[ai][bj][m][0] * (S_MIX / (S_MRG * S_WP)), v1 = acc[ai][bj][m][1] * (S_MIX / (S_MRG * S_WP));
                    u32x2 w; w.x = pk4_fp8(v0.x, v0.y, v0.z, v0.w); w.y = pk4_fp8(v1.x, v1.y, v1.z, v1.w);
                    *(u32x2*)(M8 + pbase + (size_t)(row0 + ai * 128 + m * 16) * 1024 + col0 + bj * 128) = w; }
    }
};

__device__ __forceinline__ void p7_ln1_router(Frame& F) {
    const Params& P = *F.p;
    constexpr int RS = 2064;
    LAS unsigned char* WT = F.lds;
    LAS unsigned char* HT = F.lds + 16 * RS;
    LAS f32x4* RED = (LAS f32x4*)(F.lds + 32 * RS);
    const float* wr = P.in[I_WR];
    { f32x4 wv[8];
#pragma unroll
      for (int j = 0; j < 8; ++j) wv[j] = *((const f32x4*)wr + F.tid + NTHREADS * j);
#pragma unroll
      for (int j = 0; j < 8; ++j) { const int idx = F.tid + NTHREADS * j, k = idx >> 2, e4 = idx & 3;
#pragma unroll
        for (int t = 0; t < 4; ++t) *(LAS unsigned short*)(WT + (4 * e4 + t) * RS + k * 2) = (unsigned short)(cvt_pk_bf16(wv[j][t], 0.f) & 0xffffu); } }
    __syncthreads();
    const float* mod = (const float*)(P.ws + WS_MOD); const bf16_t* MIX = (const bf16_t*)(P.ws + WS_MIX); const bf16_t* MIX2 = (const bf16_t*)(P.ws + WS_MIX2);
    bf16_t* X1B = (bf16_t*)(P.ws + WS_X1B); unsigned char* H2 = (unsigned char*)(P.ws + WS_H2); float* aff = (float*)(P.ws + WS_AFF); int* sel = (int*)(P.ws + WS_SEL);
    const int lane = F.lane, w = F.wave;
    f32x4 xv[2][4]; unsigned mv[2][4];
#define P7_LOAD(BLK) do { _Pragma("unroll") for (int rr = 0; rr < 2; ++rr) { const int m_ = (BLK) * 16 + 2 * w + rr; \
        _Pragma("unroll") for (int j = 0; j < 4; ++j) { xv[rr][j] = *((const f32x4*)xrow_ptr(P, m_) + lane + 64 * j); mv[rr][j] = *((const unsigned*)((const unsigned char*)MIX + (size_t)m_ * D) + lane + 64 * j); } } } while (0)
    f32x4 lg[4], lb[4];
#pragma unroll
    for (int j = 0; j < 4; ++j) { lg[j] = *((const f32x4*)P.in[I_LN1G] + lane + 64 * j); lb[j] = *((const f32x4*)P.in[I_LN1B] + lane + 64 * j); }
    if (F.vcu < NTOK / 16) P7_LOAD(F.vcu);
    for (int blk = F.vcu; blk < NTOK / 16; blk += F.G) {
        const int row0 = blk * 16; const float* md = mod + mod_row(row0) * 6144;
        f32x4 mg1[4], msh[4], msc[4];
#pragma unroll
        for (int j = 0; j < 4; ++j) { mg1[j] = *((const f32x4*)(md + 2048) + lane + 64 * j); msh[j] = *((const f32x4*)(md + 3072) + lane + 64 * j); msc[j] = *((const f32x4*)(md + 4096) + lane + 64 * j); }
        f32x4 vv[2][4]; float s_[2];
        const bool extra = row0 >= ROW_LO;
#pragma unroll
        for (int rr = 0; rr < 2; ++rr) { s_[rr] = 0.f;
            unsigned ex[3][4];
            if (extra) {
#pragma unroll
                for (int p = 0; p < 3; ++p)
#pragma unroll
                    for (int j = 0; j < 4; ++j) ex[p][j] = *((const unsigned*)((const unsigned char*)MIX2 + ((size_t)p * 4096 + (row0 - ROW_LO + 2 * w + rr)) * D) + lane + 64 * j);
                asm volatile("" ::: "memory");
            }
#pragma unroll
            for (int j = 0; j < 4; ++j) {
                f32x4 mx = fp8x4_f32(mv[rr][j]);
                if (extra) {
#pragma unroll
                    for (int p = 0; p < 3; ++p) mx = mx + fp8x4_f32(ex[p][j]); }
                vv[rr][j] = xv[rr][j] * ALPHA + mg1[j] * (1.0f / S_MIX) * mx; s_[rr] += (vv[rr][j].x + vv[rr][j].y) + (vv[rr][j].z + vv[rr][j].w); } }
        asm volatile("" :: "v"(msh[0]), "v"(msh[1]), "v"(msh[2]), "v"(msh[3]), "v"(msc[0]), "v"(msc[1]), "v"(msc[2]), "v"(msc[3]));
        if (blk + F.G < NTOK / 16) P7_LOAD(blk + F.G);
#pragma unroll
        for (int rr = 0; rr < 2; ++rr) {
            const int m = row0 + 2 * w + rr;
            f32x4 v[4]; float s = s_[rr];
#pragma unroll
            for (int j = 0; j < 4; ++j) v[j] = vv[rr][j];
            float mean = wave_sum(s) * (1.f / D), s2 = 0.f;
#pragma unroll
            for (int j = 0; j < 4; ++j) { v[j] = v[j] - mean; s2 += (v[j].x * v[j].x + v[j].y * v[j].y) + (v[j].z * v[j].z + v[j].w * v[j].w); }
            float rstd = 1.f / sqrtf(wave_sum(s2) * (1.f / D) + LN_EPS);
            u32x2* xr = (u32x2*)(X1B + (size_t)m * D) + lane;
            s = 0.f;
#pragma unroll
            for (int j = 0; j < 4; ++j) { const f32x4 g = lg[j], b = lb[j];
                v[j] = v[j] * rstd * g + b; u32x2 wv; wv.x = cvt_pk_bf16(v[j].x, v[j].y); wv.y = cvt_pk_bf16(v[j].z, v[j].w); xr[64 * j] = wv; s += (v[j].x + v[j].y) + (v[j].z + v[j].w); }
            mean = wave_sum(s) * (1.f / D); s2 = 0.f;
#pragma unroll
            for (int j = 0; j < 4; ++j) { v[j] = v[j] - mean; s2 += (v[j].x * v[j].x + v[j].y * v[j].y) + (v[j].z * v[j].z + v[j].w * v[j].w); }
            rstd = 1.f / sqrtf(wave_sum(s2) * (1.f / D) + LN_EPS);
            unsigned* o4 = (unsigned*)(H2 + (size_t)m * D) + lane;
#pragma unroll
            for (int j = 0; j < 4; ++j) { const f32x4 sh = msh[j], sc = msc[j];
                v[j] = v[j] * rstd * (sc + 1.0f) + sh;
                o4[64 * j] = pk4_fp8(v[j].x, v[j].y, v[j].z, v[j].w);
                u32x2 wv; wv.x = cvt_pk_bf16(v[j].x, v[j].y); wv.y = cvt_pk_bf16(v[j].z, v[j].w);
                *(LAS u32x2*)(HT + (2 * w + rr) * RS + (4 * lane + 256 * j) * 2) = wv; }
        }
        __syncthreads();
        f32x4 acc = {0.f, 0.f, 0.f, 0.f};
#pragma unroll
        for (int ks = 0; ks < 4; ++ks) { const int kb = (128 * w + 32 * ks + 8 * (lane >> 4)) * 2;
            const bf16x8 a = *(const LAS bf16x8*)(HT + (lane & 15) * RS + kb), b = *(const LAS bf16x8*)(WT + (lane & 15) * RS + kb);
            acc = __builtin_amdgcn_mfma_f32_16x16x32_bf16(a, b, acc, 0, 0, 0); }
        RED[w * 64 + lane] = acc;
        __syncthreads();
        if (F.tid < 256) { const int r = F.tid >> 4, e = F.tid & 15, ln = (r >> 2) * 16 + e, rg = r & 3; float lg = 0.f;
#pragma unroll
            for (int ww = 0; ww < 8; ++ww) lg += RED[ww * 64 + ln][rg];
            float mx = lg;
#pragma unroll
            for (int o = 1; o < 16; o <<= 1) mx = fmaxf(mx, __shfl_xor(mx, o));
            const float ex = expf(lg - mx); float sm = ex;
#pragma unroll
            for (int o = 1; o < 16; o <<= 1) sm += __shfl_xor(sm, o);
            aff[(size_t)e * NTOK + row0 + r] = ex / sm; sel[(size_t)(row0 + r) * 16 + e] = -1; }
        __syncthreads();
    }
}

__device__ __forceinline__ unsigned wave_suffix_incl(unsigned v, int lane) {
#pragma unroll
    for (int o = 1; o < 64; o <<= 1) { const unsigned t = __shfl_down(v, o); if (lane + o < 64) v += t; }
    return v;
}
__device__ __forceinline__ unsigned wave_prefix_excl(unsigned v, int lane) {
    const unsigned own = v;
#pragma unroll
    for (int o = 1; o < 64; o <<= 1) { const unsigned t = __shfl_up(v, o); if (lane >= o) v += t; }
    return v - own;
}
__device__ __forceinline__ void p8_topk(Frame& F) {
    const Params& P = *F.p;
    if (F.vcu < 32) {
        if (F.tid == 0) {
            unsigned* c = (unsigned*)(P.ws + WS_CTL) + 320; unsigned spins = 0;
            while (__hip_atomic_load(c, __ATOMIC_RELAXED, __HIP_MEMORY_SCOPE_AGENT) < (unsigned)F.G) { __builtin_amdgcn_s_sleep(4); if (++spins > (1u << 24)) break; }
            __builtin_amdgcn_fence(__ATOMIC_ACQUIRE, "agent"); asm volatile("s_waitcnt vmcnt(0)" ::: "memory");
        }
        __syncthreads();
        const int g = F.vcu >> 4, e = F.vcu & 15;
        const int n = g ? NS : NP, cap = n / 8, base = g ? NP : 0, sbase = e * SLOTS_E + (g ? CAP_P : 0);
        LAS unsigned* keys = (LAS unsigned*)F.lds;
        LAS unsigned* hist = keys + 16384;
        LAS unsigned* misc = hist + 256;
        LAS unsigned* cgt = misc + 64;
        LAS unsigned* ceq = cgt + 256;
        const float* aff = (const float*)(P.ws + WS_AFF) + (size_t)e * NTOK + base;
        { f32x4 kv[8];
#pragma unroll
          for (int j = 0; j < 8; ++j) { const int i = F.tid + NTHREADS * j; kv[j] = (i < n / 4) ? *((const f32x4*)aff + i) : (f32x4){0.f, 0.f, 0.f, 0.f}; }
#pragma unroll
          for (int j = 0; j < 8; ++j) { const int i = F.tid + NTHREADS * j; if (i < n / 4) *((LAS u32x4*)keys + i) = (u32x4){__float_as_uint(kv[j].x), __float_as_uint(kv[j].y), __float_as_uint(kv[j].z), __float_as_uint(kv[j].w)}; } }
        unsigned prefix = 0u, mask = 0u, need = (unsigned)cap;
        for (int pass = 0; pass < 4; ++pass) {
            const int shift = 24 - 8 * pass;
            if (F.tid < 256) hist[F.tid] = 0u;
            __syncthreads();
            for (int i = F.tid; i < n; i += NTHREADS) { const unsigned k = keys[i]; if ((k & mask) == prefix) atomicAdd((unsigned*)&hist[(k >> shift) & 255u], 1u); }
            __syncthreads();
            unsigned mine = 0u, sfx = 0u;
            if (F.tid < 256) { mine = hist[F.tid]; sfx = wave_suffix_incl(mine, F.lane); if (F.lane == 0) misc[8 + F.wave] = sfx; }
            __syncthreads();
            if (F.tid < 256) { for (int w = F.wave + 1; w < 4; ++w) sfx += misc[8 + w];
                const unsigned above = sfx - mine;
                if (above < need && sfx >= need) { misc[0] = (unsigned)F.tid; misc[1] = need - above; } }
            __syncthreads();
            prefix |= misc[0] << shift; mask |= 255u << shift; need = misc[1];
            __syncthreads();
        }
        const unsigned T = prefix;
        int* list = (int*)(P.ws + WS_LIST); float* gate = (float*)(P.ws + WS_GATE); int* sel = (int*)(P.ws + WS_SEL);
        const int nit = n / NTHREADS;
        for (int it = 0; it < nit; ++it) { const unsigned k = keys[it * NTHREADS + F.tid];
            const unsigned long long bg = __ballot(k > T), be = __ballot(k == T);
            if (F.lane == 0) { cgt[it * 8 + F.wave] = (unsigned)__popcll(bg); ceq[it * 8 + F.wave] = (unsigned)__popcll(be); } }
        if (F.tid >= nit * 8 && F.tid < 256) { cgt[F.tid] = 0u; ceq[F.tid] = 0u; }
        __syncthreads();
        if (F.wave < 4) {
            const unsigned a = cgt[F.tid], b = ceq[F.tid];
            const unsigned pa = wave_prefix_excl(a, F.lane), pb = wave_prefix_excl(b, F.lane);
            if (F.lane == 63) { misc[16 + F.wave] = pa + a; misc[24 + F.wave] = pb + b; }
            __syncthreads();
            unsigned oa = 0u, ob = 0u; for (int w = 0; w < F.wave; ++w) { oa += misc[16 + w]; ob += misc[24 + w]; }
            cgt[F.tid] = pa + oa; ceq[F.tid] = pb + ob;
        } else __syncthreads();
        __syncthreads();
        const unsigned long long lt = (1ull << F.lane) - 1ull;
        for (int it = 0; it < nit; ++it) { const int i = it * NTHREADS + F.tid; const unsigned k = keys[i];
            const bool gt = k > T, eq = k == T;
            const unsigned long long bg = __ballot(gt), be = __ballot(eq);
            const unsigned pg = cgt[it * 8 + F.wave] + (unsigned)__popcll(bg & lt), pe = ceq[it * 8 + F.wave] + (unsigned)__popcll(be & lt);
            if (gt || (eq && pe < need)) { const int slot = sbase + (int)(pg + (pe < need ? pe : need));
                list[slot] = base + i; gate[slot] = __uint_as_float(k); sel[(size_t)(base + i) * 16 + e] = slot; } }
    } else {
        unsigned* ctr = (unsigned*)(P.ws + WS_CTL); LAS unsigned* slot = (LAS unsigned*)(F.lds + LDS_BYTES - 64);
        for (;;) {
            if (F.tid == 0) *slot = atomicAdd(ctr + 192, 4u);
            __syncthreads();
            const int b0 = CONV_P3 + (int)*slot;
            __syncthreads();
            if (b0 >= CONV_TOTAL) break;
            conv_batch(P, F.lds, F.tid, b0, 4);
        }
    }
}

struct SchedMoe1 {
    struct U { int e, mt, nt_, i; };
    const char* A; const char* B; const LAS int* lrow; int lda, ldb, nt, G, c;
    __device__ __forceinline__ bool next(int i, U& u) const { const int L = i * G + c; if (L >= 3520) return false; u.e = L / 220; const int r = L % 220; u.mt = r % 10; u.nt_ = r / 10; u.i = i; return true; }
    __device__ __forceinline__ int nt_u(const U&) const { return nt; }
    __device__ __forceinline__ const char* a_base(const U&) const { return A; }
    __device__ __forceinline__ unsigned a_row(const U& u, int r) const { return (unsigned)lrow[u.i * 256 + r]; }
    __device__ __forceinline__ const char* b_base(const U& u) const { return B + ((size_t)u.e * 5632 + (size_t)u.nt_ * 256) * ldb; }
};
struct EpiMoe1 {
    static constexpr bool HAS_MID = false;
    unsigned char* HID;
    __device__ __forceinline__ void operator()(const f32x4 (&acc)[2][2][4][2], const SchedMoe1::U& u, int wr, int wc, int fr, int fq) const {
        const int row0 = u.e * SLOTS_E + u.mt * 256 + wr * 64 + fr, col0 = u.nt_ * 128 + wc * 32 + 8 * fq;
        constexpr float IS = 1.0f / S_W1;
#pragma unroll
        for (int ai = 0; ai < 2; ++ai)
#pragma unroll
            for (int m = 0; m < 4; ++m) {
                float t[8];
#pragma unroll
                for (int n = 0; n < 2; ++n)
#pragma unroll
                    for (int j = 0; j < 4; ++j) t[4 * n + j] = siluf_(acc[ai][0][m][n][j] * IS) * (acc[ai][1][m][n][j] * (IS * S_HID));
                u32x2 w; w.x = pk4_fp8(t[0], t[1], t[2], t[3]); w.y = pk4_fp8(t[4], t[5], t[6], t[7]);
                *(u32x2*)(HID + (size_t)(row0 + ai * 128 + m * 16) * FF + col0) = w;
            }
    }
};

constexpr int YE2_SLOT0 = 12 * SLOTS_E + 8 * 256;
constexpr size_t WS_YE2 = WS_WGU + (size_t)140 * 1024 * 1024;
static_assert(WS_YE2 >= WS_WD + (size_t)16 * 1024 * FF && WS_YE2 + (size_t)(NSLOT - YE2_SLOT0) * 1024 * 2 <= WS_A, "ye2 placement");
struct SchedMoe2 {
    struct U { int e, mt, n2, ks, nt; };
    const char* A; const char* B; int lda, ldb, G, c;
    __device__ __forceinline__ bool next(int i, U& u) const {
        if (i > 2) return false;
        int L;
        if (i < 2) { L = i * G + c; u.ks = 0; u.nt = 22; } else { L = 2 * G + (c >> 1); u.ks = c & 1; u.nt = u.ks ? 10 : 12; }
        if (L >= 640) return false;
        u.n2 = L & 3; const int mg = L >> 2; u.e = mg / 10; u.mt = mg % 10; return true; }
    __device__ __forceinline__ int nt_u(const U& u) const { return u.nt; }
    __device__ __forceinline__ const char* a_base(const U& u) const { return A + (size_t)u.ks * 1536; }
    __device__ __forceinline__ unsigned a_row(const U& u, int r) const { return (unsigned)(u.e * SLOTS_E + u.mt * 256 + r); }
    __device__ __forceinline__ const char* b_base(const U& u) const { return B + ((size_t)u.e * 1024 + (size_t)u.n2 * 256) * ldb + (size_t)u.ks * 1536; }
};
struct EpiMoe2 {
    static constexpr bool HAS_MID = false;
    bf16_t* YE; bf16_t* YE2; const float* gate;
    __device__ __forceinline__ void operator()(const f32x4 (&acc)[2][2][4][2], const SchedMoe2::U& u, int wr, int wc, int fr, int fq) const {
        const int row0 = u.e * SLOTS_E + u.mt * 256 + wr * 64 + fr, col0 = u.n2 * 256 + wc * 32 + 8 * fq;
        unsigned char* Y = u.ks ? (unsigned char*)YE2 - (size_t)YE2_SLOT0 * 1024 : (unsigned char*)YE;
#pragma unroll
        for (int ai = 0; ai < 2; ++ai)
#pragma unroll
            for (int m = 0; m < 4; ++m) { const int row = row0 + ai * 128 + m * 16; const float gt = gate[row] * (S_YE / (S_HID * S_W2));
#pragma unroll
                for (int bj = 0; bj < 2; ++bj) { const f32x4 v0 = acc[ai][bj][m][0] * gt, v1 = acc[ai][bj][m][1] * gt;
                    u32x2 w; w.x = pk4_fp8(v0.x, v0.y, v0.z, v0.w); w.y = pk4_fp8(v1.x, v1.y, v1.z, v1.w);
                    *(u32x2*)(Y + (size_t)row * 1024 + col0 + bj * 128) = w; } }
    }
};

__device__ __forceinline__ void p11_final(Frame& F) {
    const Params& P = *F.p;
    const float* mod = (const float*)(P.ws + WS_MOD); const int* sel = (const int*)(P.ws + WS_SEL);
    const unsigned char* Y8 = (const unsigned char*)(P.ws + WS_YE); const unsigned char* Y82 = (const unsigned char*)(P.ws + WS_YE2);
    const int gw = F.vcu * NWAVES + F.wave, NGW = F.G * NWAVES, lane = F.lane;
    const bf16_t* X1B = (const bf16_t*)(P.ws + WS_X1B);
    LAS f32x4* MG2L = (LAS f32x4*)F.lds;
    LAS int* SELW = (LAS int*)(F.lds + 9 * 4096) + F.wave * (16 * 192);
    const int nrow = (gw < NTOK) ? (NTOK - gw + NGW - 1) / NGW : 0;
    { f32x4 t[5];
#pragma unroll
      for (int u = 0; u < 5; ++u) { const int q = F.tid + NTHREADS * u; if (q < 9 * 256) t[u] = *((const f32x4*)(mod + (q >> 8) * 6144 + 5120) + (q & 255)); }
      if (nrow > 0) { int sv[4];
#pragma unroll
        for (int u = 0; u < 4; ++u) { const int k = 4 * u + (lane >> 4), kc = (k < nrow) ? k : nrow - 1; sv[u] = sel[(size_t)(gw + kc * NGW) * 16 + (lane & 15)]; }
#pragma unroll
        for (int u = 0; u < 4; ++u) { const int k = 4 * u + (lane >> 4); if (k < nrow) SELW[k * 16 + (lane & 15)] = sv[u]; } }
      for (int k0 = 16; k0 < nrow; k0 += 4) { const int k = k0 + (lane >> 4); if (k < nrow) SELW[k * 16 + (lane & 15)] = sel[(size_t)(gw + k * NGW) * 16 + (lane & 15)]; }
#pragma unroll
      for (int u = 0; u < 5; ++u) { const int q = F.tid + NTHREADS * u; if (q < 9 * 256) MG2L[q] = t[u]; } }
    __syncthreads();
    f32x4 lg[4], lb[4];
#pragma unroll
    for (int j = 0; j < 4; ++j) { lg[j] = *((const f32x4*)P.in[I_LN2G] + lane + 64 * j); lb[j] = *((const f32x4*)P.in[I_LN2B] + lane + 64 * j); }
#define P11_SLOTS(SN, S0, S1) do { const unsigned mk_ = (unsigned)(__ballot((SN) >= 0) & 0xffffull), m2_ = mk_ & (mk_ - 1u); \
        const int r0_ = __builtin_amdgcn_readlane((SN), mk_ ? __builtin_ctz(mk_) : 0), r1_ = __builtin_amdgcn_readlane((SN), m2_ ? __builtin_ctz(m2_) : 0); \
        S0 = mk_ ? r0_ : -1; S1 = m2_ ? r1_ : -1; } while (0)
#define P11_GATHER(SN, A, A2) do { int s0_, s1_; P11_SLOTS(SN, s0_, s1_); \
        const size_t o0_ = (size_t)(s0_ < 0 ? 0 : s0_) * 1024, o1_ = (size_t)(s1_ < 0 ? 0 : s1_) * 1024, q0_ = (size_t)(s0_ < YE2_SLOT0 ? 0 : s0_ - YE2_SLOT0) * 1024, q1_ = (size_t)(s1_ < YE2_SLOT0 ? 0 : s1_ - YE2_SLOT0) * 1024; \
        _Pragma("unroll") for (int j = 0; j < 4; ++j) { A[0][j] = *(const unsigned*)(Y8 + o0_ + 4 * lane + 256 * j); A[1][j] = *(const unsigned*)(Y8 + o1_ + 4 * lane + 256 * j); \
            A2[0][j] = *(const unsigned*)(Y82 + q0_ + 4 * lane + 256 * j); A2[1][j] = *(const unsigned*)(Y82 + q1_ + 4 * lane + 256 * j); } } while (0)
    u32x2 xn[4];
    unsigned Aa[2][4], A2a[2][4], Ab[2][4], A2b[2][4];
    if (nrow > 0) { const int s0r = SELW[lane & 15];
#pragma unroll
        for (int j = 0; j < 4; ++j) xn[j] = *((const u32x2*)(X1B + (size_t)gw * D) + lane + 64 * j);
        asm volatile("" ::: "memory");
        P11_GATHER(s0r, Aa, A2a); }
#define P11_ROW(K, AC, A2C, AN, A2N) do { const int k_ = (K), m = gw + k_ * NGW; \
        f32x4 v[4], mo[4]; \
        _Pragma("unroll") for (int j = 0; j < 4; ++j) v[j] = (f32x4){bflo(xn[j].x), bfhi(xn[j].x), bflo(xn[j].y), bfhi(xn[j].y)}; \
        const int myslot = SELW[k_ * 16 + (lane & 15)]; \
          \
        const int kn_ = (k_ + 1 < nrow) ? k_ + 1 : k_; \
        _Pragma("unroll") for (int j = 0; j < 4; ++j) xn[j] = *((const u32x2*)(X1B + (size_t)(gw + kn_ * NGW) * D) + lane + 64 * j);     \
        asm volatile("" ::: "memory"); \
        { const int sn_ = SELW[kn_ * 16 + (lane & 15)]; P11_GATHER(sn_, AN, A2N); } \
        int c0, c1; P11_SLOTS(myslot, c0, c1); \
        const float k0 = (c0 >= 0) ? 1.f : 0.f, k1 = (c1 >= 0) ? 1.f : 0.f, k20 = (c0 >= YE2_SLOT0) ? 1.f : 0.f, k21 = (c1 >= YE2_SLOT0) ? 1.f : 0.f; \
        _Pragma("unroll") for (int j = 0; j < 4; ++j) mo[j] = (fp8x4_f32(AC[0][j]) * k0 + fp8x4_f32(A2C[0][j]) * k20) + (fp8x4_f32(AC[1][j]) * k1 + fp8x4_f32(A2C[1][j]) * k21); \
        unsigned mask = (unsigned)(__ballot(myslot >= 0) & 0xffffull); mask &= mask - 1u; mask &= mask - 1u; \
        while (mask) {                                                 \
            const int e0 = __builtin_ctz(mask); mask &= mask - 1u; \
            const int s0 = __builtin_amdgcn_readlane(myslot, e0); \
            int s1 = -1; if (mask) { const int e1 = __builtin_ctz(mask); mask &= mask - 1u; s1 = __builtin_amdgcn_readlane(myslot, e1); } \
            unsigned a[2][4], a2[2][4]; \
            _Pragma("unroll") for (int j = 0; j < 4; ++j) { a[0][j] = *(const unsigned*)(Y8 + (size_t)s0 * 1024 + 4 * lane + 256 * j); \
                a[1][j] = (s1 >= 0) ? *(const unsigned*)(Y8 + (size_t)s1 * 1024 + 4 * lane + 256 * j) : 0u; } \
            _Pragma("unroll") for (int j = 0; j < 4; ++j) { a2[0][j] = (s0 >= YE2_SLOT0) ? *(const unsigned*)(Y82 + (size_t)(s0 - YE2_SLOT0) * 1024 + 4 * lane + 256 * j) : 0u; \
                a2[1][j] = (s1 >= YE2_SLOT0) ? *(const unsigned*)(Y82 + (size_t)(s1 - YE2_SLOT0) * 1024 + 4 * lane + 256 * j) : 0u; } \
            _Pragma("unroll") for (int q = 0; q < 2; ++q) _Pragma("unroll") for (int j = 0; j < 4; ++j) mo[j] = mo[j] + (fp8x4_f32(a[q][j]) + fp8x4_f32(a2[q][j])); \
        } \
        float s = 0.f; \
        _Pragma("unroll") for (int j = 0; j < 4; ++j) { const f32x4 g = MG2L[mod_row(m) * 256 + lane + 64 * j] * (1.0f / S_YE); v[j] = v[j] * ALPHA + g * mo[j]; s += (v[j].x + v[j].y) + (v[j].z + v[j].w); } \
        const float mean = wave_sum(s) * (1.f / D); float s2 = 0.f; \
        _Pragma("unroll") for (int j = 0; j < 4; ++j) { v[j] = v[j] - mean; s2 += (v[j].x * v[j].x + v[j].y * v[j].y) + (v[j].z * v[j].z + v[j].w * v[j].w); } \
        const float rstd = 1.f / sqrtf(wave_sum(s2) * (1.f / D) + LN_EPS); \
        f32x4* xr = (f32x4*)(P.out + (size_t)m * D) + lane; \
        _Pragma("unroll") for (int j = 0; j < 4; ++j) xr[64 * j] = v[j] * rstd * lg[j] + lb[j]; } while (0)
    for (int k = 0; k < nrow; k += 2) {
        P11_ROW(k, Aa, A2a, Ab, A2b);
        if (k + 1 < nrow) P11_ROW(k + 1, Ab, A2b, Aa, A2a);
    }
#undef P11_ROW
#undef P11_GATHER
#undef P11_SLOTS
}

#define XB_TMO      128
#define XB_XCNT(j)  (256  + 64 * (j))
#define XB_XSUB(j)  (1280 + 64 * (j))
#define XB_XGEN(j)  (2304 + 64 * (j))
#define XB_TOP      3328
#define XB_TOPGEN   3392
#define XCD_BAR_WORDS 3456
#define XB_SPIN_CAP (1u << 22)
__device__ __forceinline__ unsigned xb_ld(unsigned* p)              { return __hip_atomic_load(p, __ATOMIC_RELAXED, __HIP_MEMORY_SCOPE_AGENT); }
__device__ __forceinline__ unsigned xb_add(unsigned* p, unsigned v) { return __hip_atomic_fetch_add(p, v, __ATOMIC_RELAXED, __HIP_MEMORY_SCOPE_AGENT); }
__device__ __forceinline__ unsigned xb_xcc_id() { return (unsigned)__builtin_amdgcn_s_getreg((3 << 11) | 20) & 0xFu; }
#define XB_SPIN(cond, bar) do { unsigned _sp = 0; while (cond) { __builtin_amdgcn_s_sleep(1); \
    if ((++_sp & 255u) == 0u) { if (xb_ld(&(bar)[XB_TMO])) break; if (_sp > XB_SPIN_CAP) { atomicAdd(&(bar)[XB_TMO], 1u); break; } } } } while (0)
struct XcdBarrier { unsigned* bar; unsigned x; volatile LAS unsigned* st; };
__device__ __forceinline__ XcdBarrier xcd_barrier_post(unsigned* bar, volatile LAS unsigned* st) {
    XcdBarrier b; b.bar = bar; b.x = xb_xcc_id(); b.st = st;
    if (threadIdx.x == 0) (void)xb_add(&bar[XB_XCNT(b.x)], 1u);
    return b;
}
__device__ __forceinline__ void xcd_barrier_complete(unsigned* bar, unsigned x, unsigned& nloc, unsigned& nx) {
    const unsigned G = gridDim.x * gridDim.y * gridDim.z;
    unsigned sum, cnt, mine, sp = 0u;
    for (;;) {
        sum = 0u; cnt = 0u; mine = 0u;
#pragma unroll
        for (unsigned j = 0; j < 16; ++j) { const unsigned c = xb_ld(&bar[XB_XCNT(j)]); sum += c; cnt += (c > 0u) ? 1u : 0u; mine = (j == x) ? c : mine; }
        if (sum == G) break;
        __builtin_amdgcn_s_sleep(1);
        if ((++sp & 255u) == 0u) { if (xb_ld(&bar[XB_TMO])) break; if (sp > XB_SPIN_CAP) { atomicAdd(&bar[XB_TMO], 1u); break; } }
    }
    nloc = mine > 0u ? mine : 1u; nx = cnt > 0u ? cnt : 1u;
}
__device__ __forceinline__ void xcd_barrier(const XcdBarrier& b) {
    asm volatile("s_waitcnt vmcnt(0)" ::: "memory");
    __syncthreads();
    if (threadIdx.x == 0) {
        unsigned* bar = b.bar;
        __builtin_amdgcn_s_waitcnt(0);
        unsigned nloc = b.st[0], nx = b.st[1];
        if (nloc == 0u) { xcd_barrier_complete(bar, b.x, nloc, nx); b.st[0] = nloc; b.st[1] = nx; }
        const unsigned old = xb_add(&bar[XB_XSUB(b.x)], 1u);
        const unsigned gen = old / nloc;
        if (old + 1u == (gen + 1u) * nloc) {
            __builtin_amdgcn_fence(__ATOMIC_RELEASE, "agent");
            asm volatile("s_waitcnt vmcnt(0)" ::: "memory");
            const unsigned og = xb_add(&bar[XB_TOP], 1u);
            const unsigned tg = og / nx;
            if (og + 1u == (tg + 1u) * nx) xb_add(&bar[XB_TOPGEN], 1u);
            else XB_SPIN(xb_ld(&bar[XB_TOPGEN]) == tg, bar);
            __builtin_amdgcn_fence(__ATOMIC_ACQUIRE, "agent");
            xb_add(&bar[XB_XGEN(b.x)], 1u);
            asm volatile("s_waitcnt vmcnt(0)" ::: "memory");
        } else {
            XB_SPIN(xb_ld(&bar[XB_XGEN(b.x)]) == gen, bar);
            __builtin_amdgcn_fence(__ATOMIC_ACQUIRE, "agent");
            asm volatile("s_waitcnt vmcnt(0)" ::: "memory");
        }
    }
    __syncthreads();
}

__global__ void __launch_bounds__(NTHREADS, 2) mega_fwd(Params P) {
    extern __shared__ __attribute__((aligned(16))) unsigned char lds_raw[];
    Frame F;
    F.lds = (LAS unsigned char*)lds_raw; F.tid = threadIdx.x; F.lane = F.tid & 63; F.wave = __builtin_amdgcn_readfirstlane(F.tid >> 6);
    F.G = gridDim.x; { const int bx = blockIdx.x; F.vcu = (F.G % 8 == 0) ? (bx % 8) * (F.G / 8) + bx / 8 : bx; }
    F.p = &P;
    {
        volatile LAS unsigned* st = (volatile LAS unsigned*)(F.lds + LDS_BYTES - 32);
        if (F.tid == 0) { st[0] = 0u; st[1] = 0u; }
        __syncthreads();
    }
    XcdBarrier xbar = xcd_barrier_post((unsigned*)(P.ws + WS_CTL + 16384), (volatile LAS unsigned*)(F.lds + LDS_BYTES - 32));
#ifdef DBG_STAMP
#define STAMP(K) do { if (((K) == DBG_STAMP || (K) == DBG_STAMP + 1) && blockIdx.x == 0 && F.tid == 0) ((unsigned long long*)(P.ws + WS_CTL + 32768))[K] = __builtin_amdgcn_s_memrealtime(); } while (0)
#else
#define STAMP(K) do {} while (0)
#endif
    STAMP(0);
#define GRID_SYNC(K) do { xcd_barrier(xbar); STAMP((K) + 1); int t_ = threadIdx.x; asm volatile("" : "+v"(t_)); F.tid = t_; F.lane = t_ & 63; F.wave = __builtin_amdgcn_readfirstlane(t_ >> 6); \
        int v_ = F.vcu; asm volatile("" : "+s"(v_)); F.vcu = v_; } while (0)

#ifndef DBG_DOUBLE
#define DBG_DOUBLE -1
#endif
#ifndef ONLY_PHASE
#define ONLY_PHASE -1
#endif
#define REPS(k) ((ONLY_PHASE >= 0 && ONLY_PHASE != (k)) ? 0 : ((DBG_DOUBLE == (k)) ? 2 : 1))
    for (int rep = 0; rep < REPS(0); ++rep) {
    p0_prologue(F);
    GRID_SYNC(0);
    }
    for (int rep = 0; rep < REPS(1); ++rep) {
    p1_ln0(F);
    GRID_SYNC(1);
    }
    for (int rep = 0; rep < REPS(2); ++rep) {
    {
        SchedIn S{(const char*)P.out, (const char*)(P.ws + WS_WIN), 1024, 1024, 16, F.G, (int)blockIdx.x};
        EpiIn E{P.ws, P.out, (const float*)(P.ws + WS_ROPE), 1.0f};
        pg8::gemm_phase(F.lds, S, E, F.tid, (DBG_GPROF == 2) ? (unsigned long long*)(P.ws + WS_CTL + 40960) : nullptr);
        SchedIn8 S8{(const char*)P.out + H8_OFF, (const char*)(P.ws + WS_WIN8), 1024, 1024, 8, F.G, (int)blockIdx.x};
        EpiIn E8{P.ws, P.out, (const float*)(P.ws + WS_ROPE), 1.0f / S_WIN};
        pg8::gemm_phase<SchedIn8, EpiIn, true>(F.lds, S8, E8, F.tid);
    }
    GRID_SYNC(2);
    }
    for (int rep = 0; rep < REPS(3); ++rep) {
    p3_mixers(F, rep);
    GRID_SYNC(3);
    }
    for (int rep = 0; rep < REPS(5); ++rep) {
    {
        SchedMrg S{(const char*)(P.ws + WS_OCAT), (const char*)(P.ws + WS_WA), 2048, 2048, 16, F.G, F.vcu};
        EpiMrg E{(const bf16_t*)(P.ws + WS_GA), (const bf16_t*)(P.ws + WS_GB), (bf16_t*)(P.ws + WS_MRG), P.ws};
        pg8::gemm_phase<SchedMrg, EpiMrg, true>(F.lds, S, E, F.tid, (DBG_GPROF == 5) ? (unsigned long long*)(P.ws + WS_CTL + 40960) : nullptr);
    }
    GRID_SYNC(5);
    }
    for (int rep = 0; rep < REPS(6); ++rep) {
    {
        SchedOut S{(const char*)P.ws, (const char*)(P.ws + WS_WO), 1024, 2048, 8, F.G, F.vcu};
        EpiOut E{(bf16_t*)(P.ws + WS_MIX), (bf16_t*)(P.ws + WS_MIX2)};
        pg8::gemm_phase<SchedOut, EpiOut, true>(F.lds, S, E, F.tid, (DBG_GPROF == 6) ? (unsigned long long*)(P.ws + WS_CTL + 40960) : nullptr);
    }
    GRID_SYNC(6);
    }
    for (int rep = 0; rep < REPS(7); ++rep) {
    p7_ln1_router(F);
    asm volatile("s_waitcnt vmcnt(0)" ::: "memory"); __syncthreads();
    if (F.tid == 0) { __builtin_amdgcn_fence(__ATOMIC_RELEASE, "agent"); asm volatile("s_waitcnt vmcnt(0)" ::: "memory");
        __hip_atomic_fetch_add((unsigned*)(P.ws + WS_CTL) + 320 + rep, 1u, __ATOMIC_RELAXED, __HIP_MEMORY_SCOPE_AGENT); }
    { int t_ = threadIdx.x; asm volatile("" : "+v"(t_)); F.tid = t_; F.lane = t_ & 63; F.wave = __builtin_amdgcn_readfirstlane(t_ >> 6); int v_ = F.vcu; asm volatile("" : "+s"(v_)); F.vcu = v_; }
    }
    for (int rep = 0; rep < REPS(8); ++rep) {
    p8_topk(F);
    GRID_SYNC(8);
    }
    for (int rep = 0; rep < REPS(9); ++rep) {
    {
        LAS int* lrow = (LAS int*)(F.lds + 131072);
        { const int* list = (const int*)(P.ws + WS_LIST);
          for (int q = F.tid; q < 14 * 256; q += NTHREADS) { const int i = q >> 8, L = i * F.G + F.vcu; if (L < 3520) { const int e = L / 220, mt = (L % 220) % 10; lrow[q] = list[e * SLOTS_E + mt * 256 + (q & 255)]; } }
          __syncthreads(); }
        SchedMoe1 S{(const char*)(P.ws + WS_H2), (const char*)(P.ws + WS_WGU), lrow, 1024, 1024, 8, F.G, F.vcu};
        EpiMoe1 E{(unsigned char*)(P.ws + WS_HID)};
        pg8::gemm_phase<SchedMoe1, EpiMoe1, true>(F.lds, S, E, F.tid, (DBG_GPROF == 9) ? (unsigned long long*)(P.ws + WS_CTL + 40960) : nullptr);
    }
    GRID_SYNC(9);
    }
    for (int rep = 0; rep < REPS(10); ++rep) {
    {
        SchedMoe2 S{(const char*)(P.ws + WS_HID), (const char*)(P.ws + WS_WD), FF, FF, F.G, F.vcu};
        EpiMoe2 E{(bf16_t*)(P.ws + WS_YE), (bf16_t*)(P.ws + WS_YE2), (const float*)(P.ws + WS_GATE)};
        pg8::gemm_phase<SchedMoe2, EpiMoe2, true>(F.lds, S, E, F.tid, (DBG_GPROF == 10) ? (unsigned long long*)(P.ws + WS_CTL + 40960) : nullptr);
    }
    GRID_SYNC(10);
    }
    if (ONLY_PHASE < 0 || ONLY_PHASE == 11) p11_final(F);
#ifdef DBG_STAMP
    GRID_SYNC(11);
    {
        const unsigned long long* ts = (const unsigned long long*)(P.ws + WS_CTL + 32768);
        const float us = (DBG_GPROF >= 0) ? (float)(((const unsigned long long*)(P.ws + WS_CTL + 40960))[DBG_GQ]) * 0.01f : (float)(ts[DBG_STAMP + 1] - ts[DBG_STAMP]) * 0.01f;
        for (size_t i = (size_t)blockIdx.x * NTHREADS + F.tid; i < O_YS; i += (size_t)F.G * NTHREADS) P.out[i] += DBG_C * us;
    }
#endif
#ifdef DBG_ZERO_MASK
    GRID_SYNC(12);
    {
        const size_t starts[7] = {O_YP, O_YS, O_NK, O_NV, O_NF, O_NB, O_END};
        for (int o = 0; o < 6; ++o) if ((DBG_ZERO_MASK >> o) & 1)
            for (size_t i = starts[o] + (size_t)blockIdx.x * NTHREADS + F.tid; i < starts[o + 1]; i += (size_t)F.G * NTHREADS) P.out[i] = 0.f;
    }
#endif
}

extern "C" void kernel_launch(void* const* d_in, const int* in_sizes, int n_in, void* d_out, int out_size, void* d_ws, size_t ws_size, hipStream_t stream) {
    static int grid = 0;
    if (grid == 0) {
        if (n_in != 32 || out_size != (int)O_END || ws_size < WS_END) { fprintf(stderr, "kernel_launch: unexpected shapes: n_in %d out %d ws %zu (need %zu)\n", n_in, out_size, ws_size, (size_t)WS_END); grid = -1; return; }
        int dev = 0, cus = 0, per_cu = 0;
        if (hipGetDevice(&dev) != hipSuccess || hipDeviceGetAttribute(&cus, hipDeviceAttributeMultiprocessorCount, dev) != hipSuccess) { grid = -1; return; }
        if (hipFuncSetAttribute((const void*)mega_fwd, hipFuncAttributeMaxDynamicSharedMemorySize, LDS_BYTES) != hipSuccess) { fprintf(stderr, "kernel_launch: hipFuncSetAttribute failed\n"); grid = -1; return; }
        if (hipOccupancyMaxActiveBlocksPerMultiprocessor(&per_cu, (const void*)mega_fwd, NTHREADS, LDS_BYTES) != hipSuccess || per_cu < 1) { fprintf(stderr, "kernel_launch: occupancy query says %d\n", per_cu); per_cu = 1; }
        (void)hipGetLastError();
        if (cus < 256) { fprintf(stderr, "kernel_launch: this kernel's static phase schedules need 256 CUs (found %d)\n", cus); grid = -1; return; }
        grid = 256;
    }
    if (grid < 0) return;
    (void)hipMemsetAsync((char*)d_ws + WS_CTL, 0, 65536, stream);
    Params p{};
    for (int i = 0; i < 32; ++i) p.in[i] = (const float*)d_in[i];
    p.out = (float*)d_out; p.ws = (unsigned char*)d_ws;
    hipLaunchKernelGGL(mega_fwd, dim3(grid), dim3(NTHREADS), LDS_BYTES, stream, p);
    hipError_t e = hipPeekAtLastError();
    if (e != hipSuccess) fprintf(stderr, "kernel_launch: launch failed: %s (grid %d)\n", hipGetErrorString(e), grid);
}
```

```cpp
#ifndef DBG_ZERO_MASK
#endif
#ifndef DBG_C
#define DBG_C 5e-5f
#endif
#ifndef DBG_GPROF
#define DBG_GPROF -1
#endif
#ifndef DBG_GQ
#define DBG_GQ 0
#endif
#include <hip/hip_runtime.h>
#include <hip/hip_cooperative_groups.h>
#include <cstdio>
#include <cstdint>
namespace cg = cooperative_groups;

#define LAS __attribute__((address_space(3)))
typedef unsigned short bf16_t;
typedef short bf16x8 __attribute__((ext_vector_type(8)));
typedef short s16x4 __attribute__((ext_vector_type(4)));
typedef float f32x2 __attribute__((ext_vector_type(2)));
typedef float f32x4 __attribute__((ext_vector_type(4)));
typedef float f32x16 __attribute__((ext_vector_type(16)));
typedef unsigned u32x2 __attribute__((ext_vector_type(2)));
typedef unsigned u32x4 __attribute__((ext_vector_type(4)));
typedef int i32x4 __attribute__((ext_vector_type(4)));
typedef int i32x8 __attribute__((ext_vector_type(8)));

constexpr int D = 1024, NP = 4096, NS = 16384, NTOK = 20480, SEQ_P = 256, SEQ_S = 2048, PAST = 256;
constexpr int INW = 8224, FF = 2816, NE = 16, CAP_P = 512, CAP_S = 2048, SLOTS_E = 2560, NSLOT = NE * SLOTS_E;
constexpr float LN_EPS = 1e-6f;
constexpr int NTHREADS = 512, NWAVES = 8;
constexpr int LDS_BYTES = 147456;

enum { I_XP = 0, I_XS, I_CK, I_CV, I_SF, I_SB, I_C, I_CCTX, I_WMOD, I_BMOD, I_WIN, I_WAF, I_BAF, I_WAB, I_BAB, I_GLAG, I_WPA,
       I_LQ1, I_LK1, I_LQ2, I_LK2, I_SUBG, I_WPB, I_WOUT, I_LN1G, I_LN1B, I_WR, I_WEG, I_WEU, I_WED, I_LN2G, I_LN2B };

constexpr size_t O_YP = 0, O_YS = (size_t)NP * D, O_NK = (size_t)NTOK * D, O_NV = O_NK + (size_t)NP * D, O_NF = O_NV + (size_t)NP * D,
                 O_NB = O_NF + (size_t)16 * 4 * 128 * 256, O_END = O_NB + (size_t)16 * 4 * 128 * 256;

constexpr size_t H8_OFF = (size_t)4096 * 1024 * 2;
constexpr size_t al256(size_t x) { return (x + 255) / 256 * 256; }
constexpr size_t WS_CTL = 0;
constexpr size_t WS_MOD = 65536;
constexpr size_t WS_ROPE = WS_MOD + al256(9 * 6144 * 4 + 256);
constexpr size_t WS_AFAB = WS_ROPE + al256(3072 * 4);
constexpr size_t WS_AFF = WS_AFAB + (size_t)NTOK * 32 * 4;
constexpr size_t WS_SEL = WS_AFF + (size_t)NTOK * 16 * 4;
constexpr size_t WS_LIST = WS_SEL + (size_t)NTOK * 16 * 4;
constexpr size_t WS_GATE = WS_LIST + (size_t)NSLOT * 4;
constexpr size_t WS_CK = WS_GATE + (size_t)NSLOT * 4;
constexpr size_t WS_CV = WS_CK + (size_t)8 * 256 * 1024 * 2;
constexpr size_t WS_WIN = WS_CV + (size_t)8 * 256 * 1024 * 2;
constexpr size_t WS_WA = WS_WIN + (size_t)8192 * 1024 * 2;
constexpr size_t WS_WB = WS_WA + (size_t)1024 * 1024 * 2;
constexpr size_t WS_WO = WS_WB + (size_t)1024 * 1024 * 2;
constexpr size_t WS_WAFB = WS_WB, WS_WRB = WS_WB + 65536;
constexpr size_t WS_WIN8 = WS_WO + (size_t)1024 * 1024 * 2;
constexpr size_t WS_WGU = WS_WIN8 + (size_t)8192 * 1024;
constexpr size_t WS_A = WS_WGU + (size_t)2 * NSLOT * 1024 * 2;
constexpr size_t SZ_T = (size_t)NTOK * 1024 * 2;
constexpr size_t WS_QA = WS_A, WS_KA = WS_QA + SZ_T / 2, WS_VA = WS_KA + SZ_T / 2, WS_QD = WS_VA + SZ_T, WS_KD = WS_QD + SZ_T,
                 WS_VD = WS_KD + SZ_T, WS_RA = WS_VD + SZ_T, WS_GA = WS_RA + SZ_T, WS_GB = WS_GA + SZ_T, WS_A_END = WS_GB + SZ_T;
constexpr size_t WS_MRG = WS_KD, WS_MIX = WS_VD, WS_H2 = WS_GA, WS_X1B = WS_GB, WS_HID = WS_A;
constexpr size_t WS_C = WS_A_END;
constexpr size_t WS_OCAT = WS_C, WS_OF = WS_OCAT + 2 * SZ_T, WS_OB = WS_OF + SZ_T, WS_END = WS_OB + SZ_T;
constexpr size_t WS_MRG2 = WS_OF;
constexpr size_t WS_MIX2 = WS_OB;
constexpr int ROW_LO = 16384;
constexpr size_t WS_WD = WS_WGU + (size_t)16 * 5632 * 1024;
constexpr size_t WS_YE = WS_WGU;
static_assert((size_t)NSLOT * FF <= WS_H2 - WS_A, "hid overlaps h2");
static_assert((size_t)16 * 5632 * 1024 + (size_t)16 * 1024 * FF <= (size_t)2 * NSLOT * 1024 * 2 && (size_t)NSLOT * 1024 * 2 <= (size_t)16 * 5632 * 1024, "expert weight / ye layout");
static_assert((size_t)16 * 5632 * 1024 <= (size_t)2 * NSLOT * 1024 * 2, "fp8 gate/up weights do not fit");
static_assert(WS_END <= 738197504ull, "workspace budget");

struct Params { const float* in[32]; float* out; unsigned char* ws; };

typedef __bf16 bf16x2_t __attribute__((ext_vector_type(2)));
__device__ __forceinline__ unsigned cvt_pk_bf16(float lo, float hi) { const f32x2 v = {lo, hi}; return __builtin_bit_cast(unsigned, __builtin_convertvector(v, bf16x2_t)); }
constexpr float S_W1 = 64.f, S_HID = 4.f, S_W2 = 128.f, S_WIN = 32.f, S_WP = 32.f, S_MRG = 4, S_YE = 32.f, S_MIX = 16.f;
__device__ __forceinline__ unsigned pk4_fp8(float a, float b, float c, float d) {
    a = __builtin_amdgcn_fmed3f(a, -440.f, 440.f); b = __builtin_amdgcn_fmed3f(b, -440.f, 440.f); c = __builtin_amdgcn_fmed3f(c, -440.f, 440.f); d = __builtin_amdgcn_fmed3f(d, -440.f, 440.f);
    int w = 0; w = __builtin_amdgcn_cvt_pk_fp8_f32(a, b, w, false); w = __builtin_amdgcn_cvt_pk_fp8_f32(c, d, w, true); return (unsigned)w;
}
__device__ __forceinline__ f32x4 fp8x4_f32(unsigned u) {
    const auto lo = __builtin_amdgcn_cvt_pk_f32_fp8((int)u, false), hi = __builtin_amdgcn_cvt_pk_f32_fp8((int)u, true); return (f32x4){lo[0], lo[1], hi[0], hi[1]};
}
__device__ __forceinline__ float bf2f(unsigned short b) { return __uint_as_float(((unsigned)b) << 16); }
__device__ __forceinline__ float bflo(unsigned w) { return __uint_as_float(w << 16); }
__device__ __forceinline__ float bfhi(unsigned w) { return __uint_as_float(w & 0xffff0000u); }
__device__ __forceinline__ float wave_sum(float v) {
#pragma unroll
    for (int o = 1; o < 64; o <<= 1) v += __shfl_xor(v, o);
    return v;
}
__device__ __forceinline__ float sigmoidf_(float x) { return __builtin_amdgcn_rcpf(1.0f + __expf(-x)); }
__device__ __forceinline__ float siluf_(float x) { return x * __builtin_amdgcn_rcpf(1.0f + __expf(-x)); }
#define LDS_WAIT() asm volatile("s_waitcnt lgkmcnt(0)" ::: "memory")

struct Frame {
    LAS unsigned char* lds;
    int tid, lane, wave, vcu, G;
    const Params* p;
};

__device__ __forceinline__ void transpose_item(const float* __restrict__ W, size_t ldn, bf16_t* __restrict__ WT, size_t ldk, int k0, int nsrc0, size_t drow0, LAS float* scr, int lane) {
#pragma unroll 8
    for (int i = 0; i < 32; ++i) { const int kk = 2 * i + (lane >> 5); scr[kk * 33 + (lane & 31)] = W[(size_t)(k0 + kk) * ldn + nsrc0 + (lane & 31)]; }
    LDS_WAIT(); asm volatile("" ::: "memory");
    const int c = lane & 7;
#pragma unroll
    for (int j = 0; j < 4; ++j) { const int n = (lane >> 3) + 8 * j; const LAS float* s = scr + (8 * c) * 33 + n;
        u32x4 o; o.x = cvt_pk_bf16(s[0 * 33], s[1 * 33]); o.y = cvt_pk_bf16(s[2 * 33], s[3 * 33]); o.z = cvt_pk_bf16(s[4 * 33], s[5 * 33]); o.w = cvt_pk_bf16(s[6 * 33], s[7 * 33]);
        *(u32x4*)(WT + (drow0 + n) * ldk + k0 + 8 * c) = o; }
    LDS_WAIT(); asm volatile("" ::: "memory");
}


struct TrItem { const float* W; bf16_t* WT; unsigned ldn, ldk; int k0, nsrc0; unsigned drow0, dstep; int kd0; int perm; };
__device__ __forceinline__ void tr_load(const TrItem& it, int wave, int lane, f32x4 (&v)[8]) {
    const float* p = it.W + (size_t)(it.k0 + 8 * wave) * it.ldn + it.nsrc0 + 4 * lane;
#pragma unroll
    for (int i = 0; i < 8; ++i) v[i] = *(const f32x4*)(p + (size_t)i * it.ldn);
}
__device__ __forceinline__ void tr_pack_write(LAS unsigned char* T, int wave, int lane, const f32x4 (&v)[8]) {
#pragma unroll
    for (int j = 0; j < 4; ++j) { u32x4 c; c.x = cvt_pk_bf16(v[0][j], v[1][j]); c.y = cvt_pk_bf16(v[2][j], v[3][j]); c.z = cvt_pk_bf16(v[4][j], v[5][j]); c.w = cvt_pk_bf16(v[6][j], v[7][j]);
        *(LAS u32x4*)(T + (4 * lane + j) * 128 + ((wave ^ (lane & 7)) << 4)) = c; }
}
__device__ __forceinline__ void tr_store(const TrItem& it, const LAS unsigned char* T, int tid) {
#pragma unroll
    for (int r = 0; r < 4; ++r) { const int idx = tid + 512 * r, n = idx >> 3, c = idx & 7;
        const u32x4 ch = *(const LAS u32x4*)(T + n * 128 + ((c ^ ((n >> 2) & 7)) << 4));
        *(u32x4*)(it.WT + (size_t)(it.drow0 + (unsigned)(n >> 7) * it.dstep + (unsigned)(n & 127)) * it.ldk + it.kd0 + 8 * c) = ch; }
}
constexpr int TR_IN = 16 * 32, TR_PR = 3 * 16 * 4, TR_GU = 2 * 16 * 16 * 11, TR_WD = 16 * 44 * 4;
__device__ __forceinline__ TrItem tr_item_p0(const Params& P, int r) {
    TrItem it;
    if (r < TR_IN) { const int kb = r >> 5, nb = r & 31, n0 = 256 * nb; it.W = P.in[I_WIN]; it.WT = (bf16_t*)(P.ws + WS_WIN); it.ldn = INW; it.ldk = 1024; it.k0 = 64 * kb; it.nsrc0 = n0 + (n0 >= 3072 ? 32 : 0); it.drow0 = n0; it.dstep = 128; it.kd0 = it.k0; it.perm = 0; }
    else { r -= TR_IN; const int w = r >> 6, q = r & 63, kb = q >> 2, nb = q & 3;
        it.W = (w == 0) ? P.in[I_WPA] : (w == 1) ? P.in[I_WPB] : P.in[I_WOUT]; it.WT = (bf16_t*)(P.ws + ((w == 2) ? WS_WO : WS_WA));
        it.ldn = 1024; it.ldk = (w == 2) ? 1024 : 2048; it.k0 = 64 * kb; it.kd0 = 64 * kb + (w == 1 ? 1024 : 0); it.nsrc0 = 256 * nb; it.drow0 = 256 * nb; it.dstep = 128; }
    return it;
}
__device__ __forceinline__ TrItem tr_item_gu(const Params& P, int r) {
    TrItem it; const int up = r / (TR_GU / 2), q = r % (TR_GU / 2), e = q / 176, q2 = q % 176, kb = q2 / 11, nb = q2 % 11;
    it.W = (up ? P.in[I_WEU] : P.in[I_WEG]) + (size_t)e * 1024 * FF; it.WT = (bf16_t*)(P.ws + WS_WGU); it.ldn = FF; it.ldk = 1024; it.k0 = 64 * kb; it.nsrc0 = 256 * nb;
    it.drow0 = (unsigned)e * 5632u + (unsigned)nb * 512u + (up ? 128u : 0u); it.dstep = 256; it.kd0 = it.k0; it.perm = 0; return it;
}
__device__ __forceinline__ TrItem tr_item_wd(const Params& P, int r) {
    TrItem it; const int e = r / 176, q = r % 176, kb = q >> 2, nb = q & 3;
    it.W = P.in[I_WED] + (size_t)e * FF * 1024; it.WT = (bf16_t*)(P.ws + WS_WD); it.ldn = 1024; it.ldk = FF; it.k0 = 64 * kb; it.nsrc0 = 256 * nb; it.drow0 = (unsigned)e * 1024u + 256u * nb; it.dstep = 128; it.kd0 = it.k0; it.perm = 0; return it;
}

__device__ __forceinline__ void tr8_load(const TrItem& it, int wave, int lane, f32x4 (&v)[16]) {
    const float* p = it.W + (size_t)it.k0 * it.ldn + it.nsrc0 + 4 * lane;
#pragma unroll
    for (int i = 0; i < 16; ++i) { const int q = 16 * wave + i, row = it.perm ? (q & 3) * 32 + (q >> 2) : q; v[i] = *(const f32x4*)(p + (size_t)row * it.ldn); }
}
__device__ __forceinline__ void tr8_pack_write(LAS unsigned char* T, int wave, int lane, const f32x4 (&v)[16], float sc) {
#pragma unroll
    for (int j = 0; j < 4; ++j) { u32x4 c; c.x = pk4_fp8(v[0][j] * sc, v[1][j] * sc, v[2][j] * sc, v[3][j] * sc); c.y = pk4_fp8(v[4][j] * sc, v[5][j] * sc, v[6][j] * sc, v[7][j] * sc);
        c.z = pk4_fp8(v[8][j] * sc, v[9][j] * sc, v[10][j] * sc, v[11][j] * sc); c.w = pk4_fp8(v[12][j] * sc, v[13][j] * sc, v[14][j] * sc, v[15][j] * sc);
        *(LAS u32x4*)(T + (4 * lane + j) * 128 + ((wave ^ (lane & 7)) << 4)) = c; }
}
__device__ __forceinline__ void tr8_store(const TrItem& it, const LAS unsigned char* T, int tid) {
#pragma unroll
    for (int r = 0; r < 4; ++r) { const int idx = tid + 512 * r, n = idx >> 3, c = idx & 7;
        const u32x4 ch = *(const LAS u32x4*)(T + n * 128 + ((c ^ ((n >> 2) & 7)) << 4));
        *(u32x4*)((unsigned char*)it.WT + (size_t)(it.drow0 + (unsigned)(n >> 7) * it.dstep + (unsigned)(n & 127)) * it.ldk + it.kd0 + 16 * c) = ch; }
}
constexpr int TR8_GU = 2 * 16 * 8 * 11, TR8_WD = 16 * 22 * 4, TR8_IN = 8 * 32, TR8_PR = 4 * 8 * 4;
__device__ __forceinline__ TrItem tr8_item_pr(const Params& P, int r) {
    TrItem it; const int w = r >> 5, q = r & 31, kb = q >> 2, nb = q & 3;
    it.W = (w == 0) ? P.in[I_WPA] : (w == 1) ? P.in[I_WPB] : P.in[I_WOUT]; it.WT = (bf16_t*)(P.ws + ((w >= 2) ? WS_WO : WS_WA));
    it.ldn = 1024; it.ldk = 2048; it.k0 = 128 * kb; it.kd0 = 128 * kb + ((w & 1) ? 1024 : 0); it.nsrc0 = 256 * nb; it.drow0 = 256 * nb; it.dstep = 128; it.perm = (w == 1); return it;
}
__device__ __forceinline__ TrItem tr8_item_in(const Params& P, int r) {
    TrItem it; const int kb = r >> 5, nb = r & 31, n0 = 256 * nb;
    it.W = P.in[I_WIN]; it.WT = (bf16_t*)(P.ws + WS_WIN8); it.ldn = INW; it.ldk = 1024; it.k0 = 128 * kb; it.kd0 = it.k0; it.nsrc0 = n0 + (n0 >= 3072 ? 32 : 0); it.drow0 = n0; it.dstep = 128; it.perm = 0; return it;
}
__device__ __forceinline__ TrItem tr8_item_gu(const Params& P, int r) {
    TrItem it; const int up = r / (TR8_GU / 2), q = r % (TR8_GU / 2), e = q / 88, q2 = q % 88, kb = q2 / 11, nb = q2 % 11;
    it.W = (up ? P.in[I_WEU] : P.in[I_WEG]) + (size_t)e * 1024 * FF; it.WT = (bf16_t*)(P.ws + WS_WGU); it.ldn = FF; it.ldk = 1024; it.k0 = 128 * kb; it.nsrc0 = 256 * nb;
    it.drow0 = (unsigned)e * 5632u + (unsigned)nb * 512u + (up ? 128u : 0u); it.dstep = 256; it.kd0 = it.k0; it.perm = 0; return it;
}
__device__ __forceinline__ TrItem tr8_item_wd(const Params& P, int r) {
    TrItem it; const int e = r / 88, q = r % 88, kb = q >> 2, nb = q & 3;
    it.W = P.in[I_WED] + (size_t)e * FF * 1024; it.WT = (bf16_t*)(P.ws + WS_WD); it.ldn = 1024; it.ldk = FF; it.k0 = 128 * kb; it.nsrc0 = 256 * nb; it.drow0 = (unsigned)e * 1024u + 256u * nb; it.dstep = 128; it.kd0 = it.k0; it.perm = 0; return it;
}
template <int KIND> __device__ __forceinline__ void tr_run(const Params& P, LAS unsigned char* T, int tid, int first, int stride, int limit) {
    const int wave = tid >> 6, lane = tid & 63;
    if (first >= limit) return;
    if constexpr (KIND == 0) {
        f32x4 v[8]; TrItem it = tr_item_p0(P, first);
        tr_load(it, wave, lane, v);
        for (int r = first; r < limit; r += stride) {
            tr_pack_write(T, wave, lane, v);
            const TrItem cur = it;
            if (r + stride < limit) { it = tr_item_p0(P, r + stride); tr_load(it, wave, lane, v); }
            __syncthreads();
            tr_store(cur, T, tid);
            __syncthreads();
        }
    } else {
        constexpr float sc = (KIND == 1) ? S_W1 : (KIND == 2) ? S_W2 : (KIND == 3) ? S_WIN : S_WP;
        f32x4 v[16]; TrItem it = (KIND == 1) ? tr8_item_gu(P, first) : (KIND == 2) ? tr8_item_wd(P, first) : (KIND == 3) ? tr8_item_in(P, first) : tr8_item_pr(P, first);
        tr8_load(it, wave, lane, v);
        for (int r = first; r < limit; r += stride) {
            tr8_pack_write(T, wave, lane, v, sc);
            const TrItem cur = it;
            if (r + stride < limit) { it = (KIND == 1) ? tr8_item_gu(P, r + stride) : (KIND == 2) ? tr8_item_wd(P, r + stride) : (KIND == 3) ? tr8_item_in(P, r + stride) : tr8_item_pr(P, r + stride); tr8_load(it, wave, lane, v); }
            __syncthreads();
            tr8_store(cur, T, tid);
            __syncthreads();
        }
    }
}


constexpr int CONV_TOTAL = TR8_GU + TR8_WD;
__device__ __forceinline__ TrItem conv_decode(const Params& P, int item) { return (item < TR8_GU) ? tr8_item_gu(P, item) : tr8_item_wd(P, item - TR8_GU); }
#define CONV_WAIT(N, v) asm volatile("s_waitcnt vmcnt(" #N ")" : "+v"(v[0]), "+v"(v[1]), "+v"(v[2]), "+v"(v[3]), "+v"(v[4]), "+v"(v[5]), "+v"(v[6]), "+v"(v[7]), \
        "+v"(v[8]), "+v"(v[9]), "+v"(v[10]), "+v"(v[11]), "+v"(v[12]), "+v"(v[13]), "+v"(v[14]), "+v"(v[15]) :: "memory")
__device__ __forceinline__ void tr8_load_async(const TrItem& it, int wave, int lane, f32x4 (&v)[16]) {
    const float* p = it.W + ((size_t)it.k0 + 16 * wave) * it.ldn + it.nsrc0 + 4 * lane;
#pragma unroll
    for (int i = 0; i < 16; ++i) { const float* q = p + (size_t)i * it.ldn; asm volatile("global_load_dwordx4 %0, %1, off" : "=v"(v[i]) : "v"(q) : "memory"); }
}
__device__ __forceinline__ void conv_batch(const Params& P, LAS unsigned char* T, int tid_in, int base, int n) {
    int tid = tid_in; asm volatile("" : "+v"(tid));
    const int wave = tid >> 6, lane = tid & 63;
    if (base + n > CONV_TOTAL) n = CONV_TOTAL - base;
    if (n <= 0) return;
    const int last = base + n - 1;
#define CONV_IDX(j) ((base + (j) < last) ? base + (j) : last)
    asm volatile("s_waitcnt vmcnt(0)" ::: "memory");
    f32x4 va[16], vb[16]; int xa = CONV_IDX(0), xb = CONV_IDX(1);
    TrItem ia = conv_decode(P, xa), ib = conv_decode(P, xb);
    tr8_load_async(ia, wave, lane, va);
    tr8_load_async(ib, wave, lane, vb);
    CONV_WAIT(16, va);
    for (int j = 0; j < n; j += 2) {
        const TrItem ca = ia, cb = ib;
        CONV_WAIT(24, va);
        tr8_pack_write(T, wave, lane, va, (xa < TR8_GU) ? S_W1 : S_W2);
        xa = CONV_IDX(j + 2); ia = conv_decode(P, xa); tr8_load_async(ia, wave, lane, va);
        __syncthreads();
        tr8_store(ca, T, tid);
        CONV_WAIT(20, vb);
        tr8_pack_write(T + 32768, wave, lane, vb, (xb < TR8_GU) ? S_W1 : S_W2);
        xb = CONV_IDX(j + 3); ib = conv_decode(P, xb); tr8_load_async(ib, wave, lane, vb);
        __syncthreads();
        tr8_store(cb, T + 32768, tid);
    }
#undef CONV_IDX
    CONV_WAIT(0, va); CONV_WAIT(0, vb);
    __syncthreads();
}

__device__ __forceinline__ void tr16_pack_write(LAS unsigned char* T, int wave, int lane, const f32x4 (&v)[16]) {
#pragma unroll
    for (int j = 0; j < 4; ++j)
#pragma unroll
        for (int h = 0; h < 2; ++h) { u32x4 c; c.x = cvt_pk_bf16(v[8 * h + 0][j], v[8 * h + 1][j]); c.y = cvt_pk_bf16(v[8 * h + 2][j], v[8 * h + 3][j]); c.z = cvt_pk_bf16(v[8 * h + 4][j], v[8 * h + 5][j]); c.w = cvt_pk_bf16(v[8 * h + 6][j], v[8 * h + 7][j]);
            *(LAS u32x4*)(T + (4 * lane + j) * 256 + (((2 * wave + h) ^ (lane & 15)) << 4)) = c; }
}
__device__ __forceinline__ void tr16_store(const TrItem& it, bf16_t* WT, const LAS unsigned char* T, int tid) {
#pragma unroll
    for (int r = 0; r < 8; ++r) { const int idx = tid + 512 * r, n = idx >> 4, c = idx & 15;
        const u32x4 ch = *(const LAS u32x4*)(T + n * 256 + ((c ^ ((n >> 2) & 15)) << 4));
        *(u32x4*)(WT + (size_t)(it.drow0 + (unsigned)(n >> 7) * it.dstep + (unsigned)(n & 127)) * it.ldk + it.kd0 + 8 * c) = ch; }
}
__device__ __forceinline__ void p0_prologue(Frame& F) {
    const Params& P = *F.p;
    unsigned char* ws = P.ws;
    LAS float* ldsf = (LAS float*)F.lds;
    const int c = F.vcu;
    const TrItem itw = tr8_item_in(P, (c < TR8_IN) ? c : 0);
    f32x4 vw[16], vp[16];
    tr8_load(itw, F.wave, F.lane, vw);
    const TrItem itp = tr8_item_pr(P, (c < TR8_PR) ? c : 0);
    if (c < TR8_PR) tr8_load(itp, F.wave, F.lane, vp);
    if (c < 192) {
        const float* cc = P.in[I_C]; const float* cctx = P.in[I_CCTX]; const float* wm = P.in[I_WMOD]; const float* bm = P.in[I_BMOD];
        { float cv[18];
#pragma unroll
          for (int j = 0; j < 18; ++j) { const int i = F.tid + NTHREADS * j, r = i >> 10, k = i & 1023; cv[j] = (r == 0) ? cctx[k] : cc[(r - 1) * 1024 + k]; }
#pragma unroll
          for (int j = 0; j < 18; ++j) ldsf[F.tid + NTHREADS * j] = siluf_(cv[j]); }
        __syncthreads();
        const int col = F.tid & 31, kg = F.tid >> 5, k0 = kg * 64;
        float acc[9];
#pragma unroll
        for (int r = 0; r < 9; ++r) acc[r] = 0.f;
#pragma unroll
        for (int kh = 0; kh < 64; kh += 32) { float wv[32];
#pragma unroll
          for (int kk = 0; kk < 32; ++kk) wv[kk] = wm[(size_t)(k0 + kh + kk) * 6144 + 32 * c + col];
          asm volatile("" ::: "memory");
#pragma unroll
          for (int kk = 0; kk < 32; kk += 4) {
#pragma unroll
            for (int r = 0; r < 9; ++r) { const f32x4 a = *(const LAS f32x4*)(ldsf + r * 1024 + k0 + kh + kk);
                acc[r] = fmaf(a.x, wv[kk], acc[r]); acc[r] = fmaf(a.y, wv[kk + 1], acc[r]); acc[r] = fmaf(a.z, wv[kk + 2], acc[r]); acc[r] = fmaf(a.w, wv[kk + 3], acc[r]); } } }
        LAS float* red = ldsf + 9 * 1024;
#pragma unroll
        for (int r = 0; r < 9; ++r) red[(kg * 9 + r) * 32 + col] = acc[r];
        __syncthreads();
        if (F.tid < 288) { const int r = F.tid >> 5, cl = F.tid & 31; float s = 0.f;
#pragma unroll
            for (int g = 0; g < 16; ++g) s += red[(g * 9 + r) * 32 + cl];
            ((float*)(ws + WS_MOD))[r * 6144 + 32 * c + cl] = s + bm[32 * c + cl]; }
        __syncthreads();
    } else if (c == 192) {
        if (F.wave == 0) {
            const float* q1 = P.in[I_LQ1]; const float* k1 = P.in[I_LK1]; const float* q2 = P.in[I_LQ2]; const float* k2 = P.in[I_LK2];
            const float s1 = wave_sum(q1[F.lane] * k1[F.lane]), s2 = wave_sum(q2[F.lane] * k2[F.lane]);
            if (F.lane == 0) ((float*)(ws + WS_MOD))[9 * 6144] = expf(s1) - expf(s2) + 0.2f;
        }
        float* rope = (float*)(ws + WS_ROPE);
        for (int i = F.tid; i < 96 * 16; i += NTHREADS) {
            const int pos = i >> 4, j = i & 15;
            const float inv = powf(10000.0f, -(float)j / 16.0f);
            const float p = (pos < 32) ? (float)pos : (float)(pos - 32);
            float sn, cs; sincosf(p * inv, &sn, &cs);
            if (pos < 32) { rope[pos * 16 + j] = cs; rope[512 + pos * 16 + j] = sn; }
            else { rope[1024 + (pos - 32) * 16 + j] = cs; rope[2048 + (pos - 32) * 16 + j] = sn; }
        }
    }
    else if (c == 193) {
        const float* win = P.in[I_WIN]; unsigned* dst = (unsigned*)(ws + WS_WAFB);
        f32x4 r0[8], r1[8];
#pragma unroll
        for (int q = 0; q < 8; ++q) { r0[q] = *(const f32x4*)(win + (size_t)(2 * F.tid) * INW + 3072 + 4 * q); r1[q] = *(const f32x4*)(win + (size_t)(2 * F.tid + 1) * INW + 3072 + 4 * q); }
#pragma unroll
        for (int q = 0; q < 8; ++q)
#pragma unroll
            for (int t = 0; t < 4; ++t) dst[(4 * q + t) * 512 + F.tid] = cvt_pk_bf16(r0[q][t], r1[q][t]);
    } else if (c == 194) {
        const float* wr = P.in[I_WR]; unsigned* dst = (unsigned*)(ws + WS_WRB);
        f32x4 r0[4], r1[4];
#pragma unroll
        for (int q = 0; q < 4; ++q) { r0[q] = *(const f32x4*)(wr + (size_t)(2 * F.tid) * 16 + 4 * q); r1[q] = *(const f32x4*)(wr + (size_t)(2 * F.tid + 1) * 16 + 4 * q); }
#pragma unroll
        for (int q = 0; q < 4; ++q)
#pragma unroll
            for (int t = 0; t < 4; ++t) dst[(4 * q + t) * 512 + F.tid] = cvt_pk_bf16(r0[q][t], r1[q][t]);
    }
    __syncthreads();
    const size_t n8 = (size_t)8 * 256 * 1024 / 8;
    f32x4 ca[4], cb[4];
#pragma unroll
    for (int q = 0; q < 4; ++q) { const size_t i = (size_t)F.vcu * NTHREADS + F.tid + (size_t)q * F.G * NTHREADS;
        if (i < 2 * n8) { const bool isk = i < n8; const size_t j = isk ? i : i - n8; const float* src = (isk ? P.in[I_CK] : P.in[I_CV]) + j * 8; ca[q] = *(const f32x4*)src; cb[q] = *(const f32x4*)(src + 4); } }
    if (c < TR8_IN) {
        const int nb = c & 31; const bool need16 = (nb >= 2 && nb < 8) || (nb >= 16 && nb < 24);
        tr8_pack_write(F.lds, F.wave, F.lane, vw, S_WIN);
        if (need16) tr16_pack_write(F.lds + 32768, F.wave, F.lane, vw);
        __syncthreads();
        tr8_store(itw, F.lds, F.tid);
        if (need16) tr16_store(itw, (bf16_t*)(P.ws + WS_WIN), F.lds + 32768, F.tid);
        __syncthreads();
    }
    for (int r = c + F.G; r < TR8_IN; r += F.G) {
        const TrItem it2 = tr8_item_in(P, r); tr8_load(it2, F.wave, F.lane, vw);
        tr8_pack_write(F.lds, F.wave, F.lane, vw, S_WIN); tr16_pack_write(F.lds + 32768, F.wave, F.lane, vw);
        __syncthreads();
        tr8_store(it2, F.lds, F.tid); tr16_store(it2, (bf16_t*)(P.ws + WS_WIN), F.lds + 32768, F.tid);
        __syncthreads();
    }
    if (c < TR8_PR) {
        tr8_pack_write(F.lds, F.wave, F.lane, vp, S_WP);
        __syncthreads();
        tr8_store(itp, F.lds, F.tid);
        __syncthreads();
    }
    tr_run<4>(P, F.lds, F.tid, F.vcu + F.G, F.G, TR8_PR);
    {
#pragma unroll
        for (int q = 0; q < 4; ++q) { const size_t i = (size_t)F.vcu * NTHREADS + F.tid + (size_t)q * F.G * NTHREADS;
            if (i < 2 * n8) { const bool isk = i < n8; const size_t j = isk ? i : i - n8; const f32x4 a = ca[q], b = cb[q];
                u32x4 o; o.x = cvt_pk_bf16(a.x, a.y); o.y = cvt_pk_bf16(a.z, a.w); o.z = cvt_pk_bf16(b.x, b.y); o.w = cvt_pk_bf16(b.z, b.w);
                *(u32x4*)(ws + (isk ? WS_CK : WS_CV) + j * 16) = o; } }
        for (size_t i = (size_t)F.vcu * NTHREADS + F.tid + (size_t)4 * F.G * NTHREADS; i < 2 * n8; i += (size_t)F.G * NTHREADS) {
            const bool isk = i < n8; const size_t j = isk ? i : i - n8;
            const float* src = (isk ? P.in[I_CK] : P.in[I_CV]) + j * 8;
            const f32x4 a = *(const f32x4*)src, b = *(const f32x4*)(src + 4);
            u32x4 o; o.x = cvt_pk_bf16(a.x, a.y); o.y = cvt_pk_bf16(a.z, a.w); o.z = cvt_pk_bf16(b.x, b.y); o.w = cvt_pk_bf16(b.z, b.w);
            *(u32x4*)(ws + (isk ? WS_CK : WS_CV) + j * 16) = o;
        }
    }
}

__device__ __forceinline__ const float* xrow_ptr(const Params& P, int m) { return (m < NP) ? P.in[I_XP] + (size_t)m * D : P.in[I_XS] + (size_t)(m - NP) * D; }
__device__ __forceinline__ int mod_row(int m) { return (m < NP) ? 0 : 1 + ((m - NP) >> 11); }

__device__ __forceinline__ void p1_ln0(Frame& F) {
    const Params& P = *F.p;
    constexpr int RS = 2064;
    LAS unsigned char* WT = F.lds;
    LAS unsigned char* HT = F.lds + 32 * RS;
    LAS f32x4* RED = (LAS f32x4*)(F.lds + 48 * RS);
    { u32x4 wv[8];
#pragma unroll
      for (int j = 0; j < 8; ++j) wv[j] = *((const u32x4*)(P.ws + WS_WAFB) + F.tid + NTHREADS * j);
#pragma unroll
      for (int j = 0; j < 8; ++j) { const int idx = F.tid + NTHREADS * j; *(LAS u32x4*)(WT + (idx >> 7) * RS + (idx & 127) * 16) = wv[j]; } }
    __syncthreads();
    const float* mod = (const float*)(P.ws + WS_MOD);
    bf16_t* H = (bf16_t*)P.out;
    float* afab = (float*)(P.ws + WS_AFAB);
    const int lane = F.lane, w = F.wave;
    f32x4 xq[2][4];
#define P1_LOAD(BLK) do { _Pragma("unroll") for (int rr = 0; rr < 2; ++rr) _Pragma("unroll") for (int j = 0; j < 4; ++j) xq[rr][j] = *((const f32x4*)xrow_ptr(P, (BLK) * 16 + 2 * w + rr) + lane + 64 * j); } while (0)
    if (F.vcu < NTOK / 16) P1_LOAD(F.vcu);
    for (int blk = F.vcu; blk < NTOK / 16; blk += F.G) {
        const int row0 = blk * 16, mr = mod_row(row0);
        f32x4 hq[2][4], msh[4], msc[4];
#pragma unroll
        for (int j = 0; j < 4; ++j) { msh[j] = *((const f32x4*)(mod + mr * 6144) + lane + 64 * j); msc[j] = *((const f32x4*)(mod + mr * 6144 + 1024) + lane + 64 * j); }
#pragma unroll
        for (int rr = 0; rr < 2; ++rr)
#pragma unroll
            for (int j = 0; j < 4; ++j) hq[rr][j] = xq[rr][j];
        asm volatile("" :: "v"(msh[0]), "v"(msh[1]), "v"(msh[2]), "v"(msh[3]), "v"(msc[0]), "v"(msc[1]), "v"(msc[2]), "v"(msc[3]));
        if (blk + F.G < NTOK / 16) P1_LOAD(blk + F.G);
#pragma unroll
        for (int rr = 0; rr < 2; ++rr) {
            const int m = row0 + 2 * w + rr;
            f32x4 h[4]; float s = 0.f;
#pragma unroll
            for (int j = 0; j < 4; ++j) { h[j] = hq[rr][j]; s += (h[j].x + h[j].y) + (h[j].z + h[j].w); }
            const float mean = wave_sum(s) * (1.f / D); float s2 = 0.f;
#pragma unroll
            for (int j = 0; j < 4; ++j) { h[j] = h[j] - mean; s2 += (h[j].x * h[j].x + h[j].y * h[j].y) + (h[j].z * h[j].z + h[j].w * h[j].w); }
            const float rstd = 1.f / sqrtf(wave_sum(s2) * (1.f / D) + LN_EPS);
            u32x2* o8 = (u32x2*)(H + (size_t)m * D) + lane;
            unsigned* o4 = (unsigned*)((unsigned char*)P.out + H8_OFF + (size_t)m * D) + lane;
#pragma unroll
            for (int j = 0; j < 4; ++j) {
                const f32x4 sh = msh[j], sc = msc[j];
                h[j] = h[j] * rstd * (sc + 1.0f) + sh;
                u32x2 wv; wv.x = cvt_pk_bf16(h[j].x, h[j].y); wv.y = cvt_pk_bf16(h[j].z, h[j].w);
                if (m < NP) o8[64 * j] = wv;
                o4[64 * j] = pk4_fp8(h[j].x, h[j].y, h[j].z, h[j].w);
                *(LAS u32x2*)(HT + (2 * w + rr) * RS + (4 * lane + 256 * j) * 2) = wv;
            }
        }
        __syncthreads();
        f32x4 acc0 = {0.f, 0.f, 0.f, 0.f}, acc1 = {0.f, 0.f, 0.f, 0.f};
#pragma unroll
        for (int ks = 0; ks < 4; ++ks) { const int kb = (128 * w + 32 * ks + 8 * (lane >> 4)) * 2;
            const bf16x8 a = *(const LAS bf16x8*)(HT + (lane & 15) * RS + kb);
            const bf16x8 b0 = *(const LAS bf16x8*)(WT + (lane & 15) * RS + kb), b1 = *(const LAS bf16x8*)(WT + (16 + (lane & 15)) * RS + kb);
            acc0 = __builtin_amdgcn_mfma_f32_16x16x32_bf16(a, b0, acc0, 0, 0, 0); acc1 = __builtin_amdgcn_mfma_f32_16x16x32_bf16(a, b1, acc1, 0, 0, 0); }
        RED[(w * 2 + 0) * 64 + lane] = acc0; RED[(w * 2 + 1) * 64 + lane] = acc1;
        __syncthreads();
        { const int r = F.tid >> 5, c = F.tid & 31, nb = c >> 4, ln = (r >> 2) * 16 + (c & 15), rg = r & 3; float sum = 0.f;
#pragma unroll
          for (int ww = 0; ww < 8; ++ww) sum += RED[(ww * 2 + nb) * 64 + ln][rg];
          afab[(size_t)(row0 + r) * 32 + c] = sum; }
        __syncthreads();
    }
}

#define TR_STEP(O, HALF) { const bool up = (lane & (O)) != 0; _Pragma("unroll") for (int i = 0; i < (HALF); ++i) { const float a = vals[i], b = vals[i + (HALF)]; \
            const float send = up ? a : b, keep = up ? b : a; vals[i] = keep + __shfl_xor(send, (O)); } }

namespace pg8 {
constexpr int BM = 256, BK = 64, HALF = 128, HTB = HALF * BK * 2, STAGE_BYTES = 8 * HTB, NXCD = 8, WGM = 8;
__device__ __forceinline__ int lds_byte(int r, int c) { const int st = (r >> 4) * 2 + (c >> 5), rr = r & 15, cc = c & 31, ob = rr * 64 + cc * 2; return st * 1024 + (ob ^ (((ob >> 9) & 1) << 5)); }
__device__ __forceinline__ void stage_rc(int b, int& R, int& C) { const int st = b / 1024, sb = b % 1024, swz = sb ^ (((sb >> 9) & 1) << 5); R = (st >> 1) * 16 + swz / 64; C = (st & 1) * 32 + (swz % 64) / 2; }
__device__ __forceinline__ int perm32(int rho) { const int n = rho >> 4, i = rho & 15; return 8 * (i >> 2) + 4 * n + (i & 3); }

template <bool FP8> struct FragT { typedef bf16x8 type; };
template <> struct FragT<true> { typedef i32x4 type; };
template <bool FP8, class F> __device__ __forceinline__ void mma_step(f32x4& acc, const F& b0, const F& b1, const F& a0, const F& a1) {
    if constexpr (FP8) {
        const i32x8 b = __builtin_shufflevector(b0, b1, 0, 1, 2, 3, 4, 5, 6, 7), a = __builtin_shufflevector(a0, a1, 0, 1, 2, 3, 4, 5, 6, 7);
        const int one = 0x7f7f7f7f;
        asm volatile("v_mfma_scale_f32_16x16x128_f8f6f4 %0, %1, %2, %0, %3, %3 op_sel_hi:[0,0,0]" : "+v"(acc) : "v"(b), "v"(a), "v"(one));
    } else {
        acc = __builtin_amdgcn_mfma_f32_16x16x32_bf16(b0, a0, acc, 0, 0, 0);
        acc = __builtin_amdgcn_mfma_f32_16x16x32_bf16(b1, a1, acc, 0, 0, 0);
    }
}
struct NoBar { template <class PreF> __device__ __forceinline__ void operator()(PreF&&) const {} };
template <class A, class B> struct same_t { static constexpr bool v = false; };
template <class A> struct same_t<A, A> { static constexpr bool v = true; };
template <class Sched, class Epi, bool FP8 = false, class BarF = NoBar>
__device__ __forceinline__ void gemm_phase(LAS unsigned char* lds, const Sched& S, const Epi& E, const int tid, unsigned long long* prof = nullptr, BarF* bar = nullptr) {
    unsigned long long t_k = 0, t_e = 0, t_mark = prof ? __builtin_amdgcn_s_memrealtime() : 0ull; const unsigned long long t_begin = t_mark;
    const int wid = __builtin_amdgcn_readfirstlane(tid >> 6), lane = tid & 63, wr = wid >> 2, wc = wid & 3, fr = lane & 15, fq = lane >> 4;
    constexpr unsigned ES = FP8 ? 1u : 2u;
    int Rr[2], Cc[2]; unsigned voffB[2];
#pragma unroll
    for (int i = 0; i < 2; ++i) { int R, C; stage_rc(tid * 16 + i * 8192, R, C); Rr[i] = R; Cc[i] = C; const int Rb = (R & ~31) + perm32(R & 31); voffB[i] = (unsigned)(Rb * S.ldb) * ES + (unsigned)C * 2u; }
    const size_t kstep = (size_t)(BK * 2);
    const size_t hstepB = (size_t)HALF * S.ldb * ES;
    const unsigned ldsw = (unsigned)wid * 1024u;
    const int aoff = lds_byte(wr * 64 + fr, fq * 8), boff = lds_byte(wc * 32 + fr, fq * 8);
#define PG8_SA(b, h) (((b) * 2 + (h)) * HTB)
#define PG8_SB(b, h) ((4 + (b) * 2 + (h)) * HTB)
#define PG8_STAGE(bufoff, gbase, voff) do { _Pragma("unroll") for (int _i = 0; _i < 2; ++_i) \
        __builtin_amdgcn_global_load_lds((const unsigned*)((const char*)(gbase) + (voff)[_i]), (LAS unsigned*)(lds + (bufoff) + ldsw + _i * 8192), 16, 0, 0); } while (0)
#define PG8_LDA(dst, b, h) do { _Pragma("unroll") for (int m = 0; m < 4; ++m) _Pragma("unroll") for (int k = 0; k < 2; ++k) dst[m][k] = *(const LAS frag_t*)(lds + PG8_SA(b, h) + aoff + m * 2048 + k * 1024); } while (0)
#define PG8_LDB(dst, b, h) do { _Pragma("unroll") for (int n = 0; n < 2; ++n) _Pragma("unroll") for (int k = 0; k < 2; ++k) dst[n][k] = *(const LAS frag_t*)(lds + PG8_SB(b, h) + boff + n * 2048 + k * 1024); } while (0)
#define PG8_MMA(ai, bj, At, Bt) do { __builtin_amdgcn_s_setprio(1); _Pragma("unroll") for (int m = 0; m < 4; ++m) _Pragma("unroll") for (int n = 0; n < 2; ++n) \
        mma_step<FP8>(acc[ai][bj][m][n], Bt[n][0], Bt[n][1], At[m][0], At[m][1]); \
        __builtin_amdgcn_s_setprio(0); } while (0)
#define PG8_WAIT_V(n) asm volatile("s_waitcnt vmcnt(" #n ")" ::: "memory")
#define PG8_WAIT_L(n) asm volatile("s_waitcnt lgkmcnt(" #n ")" ::: "memory")
#define PG8_BAR __builtin_amdgcn_s_barrier()
#define PG8_SCHED __builtin_amdgcn_sched_barrier(0)
#define PG8_VOFFA(dst, u) do { _Pragma("unroll") for (int _h = 0; _h < 2; ++_h) _Pragma("unroll") for (int _i = 0; _i < 2; ++_i) \
        dst[_h][_i] = (unsigned)(S.a_row(u, _h * HALF + Rr[_i]) * (unsigned)S.lda) * ES + (unsigned)Cc[_i] * 2u; } while (0)
    typename Sched::U cur, nxt; int ui = 0;
    const bool has0 = S.next(0, cur);
    constexpr bool HASBAR = !same_t<BarF, NoBar>::v;
    if constexpr (HASBAR) {
        const char* cB0 = has0 ? S.b_base(cur) : nullptr;
        (*bar)([&]() { if (has0) { PG8_STAGE(PG8_SB(0, 0), cB0, voffB); PG8_STAGE(PG8_SB(0, 1), cB0 + hstepB, voffB); } });
    }
    if (!has0) return;
    f32x4 acc[2][2][4][2];
#pragma unroll
    for (int a = 0; a < 2; ++a)
#pragma unroll
        for (int b = 0; b < 2; ++b)
#pragma unroll
            for (int m = 0; m < 4; ++m)
#pragma unroll
                for (int n = 0; n < 2; ++n) acc[a][b][m][n] = (f32x4){0.f, 0.f, 0.f, 0.f};
    typedef typename FragT<FP8>::type frag_t;
    frag_t At[4][2], B0[2][2], B1[2][2];
    unsigned vA[2][2], vAn[2][2];
    PG8_VOFFA(vA, cur);
    const char* cA = S.a_base(cur); const char* cB = S.b_base(cur);
    if constexpr (HASBAR) {
        PG8_STAGE(PG8_SA(0, 0), cA, vA[0]); PG8_STAGE(PG8_SA(0, 1), cA, vA[1]);
        if (wr == 1) PG8_BAR;
        PG8_WAIT_V(2); PG8_BAR;
    } else {
        PG8_STAGE(PG8_SB(0, 0), cB, voffB); PG8_STAGE(PG8_SA(0, 0), cA, vA[0]); PG8_STAGE(PG8_SB(0, 1), cB + hstepB, voffB); PG8_STAGE(PG8_SA(0, 1), cA, vA[1]);
        if (wr == 1) PG8_BAR;
        PG8_WAIT_V(4); PG8_BAR;
    }
    PG8_STAGE(PG8_SB(1, 0), cB + kstep, voffB); PG8_STAGE(PG8_SA(1, 0), cA + kstep, vA[0]); PG8_STAGE(PG8_SB(1, 1), cB + hstepB + kstep, voffB);
    PG8_WAIT_V(6); PG8_BAR;
    for (;;) {
        const bool has_next = S.next(ui + 1, nxt);
        const int nt = S.nt_u(cur);
        const char* nA = has_next ? S.a_base(nxt) : cA; const char* nB = has_next ? S.b_base(nxt) : cB;
        if (has_next) { PG8_VOFFA(vAn, nxt); } else {
#pragma unroll
            for (int h = 0; h < 2; ++h)
#pragma unroll
                for (int i = 0; i < 2; ++i) vAn[h][i] = vA[h][i]; }
        for (int t = 0; t < nt; t += 2) {
            if constexpr (Epi::HAS_MID) { if (t == Epi::MID_T) { if constexpr (FP8) asm volatile("s_nop 15\n\ts_nop 15" ::: "memory"); E.mid(acc, cur, wr, wc, fr, fq); } }
            const bool last = (t == nt - 2);
            const char* a1 = cA + (size_t)(t + 1) * kstep;
            const char* a2 = last ? nA : cA + (size_t)(t + 2) * kstep; const char* b2 = last ? nB : cB + (size_t)(t + 2) * kstep;
            const char* a3 = a2 + kstep; const char* b3 = b2 + kstep;
            unsigned v2[2][2];
#pragma unroll
            for (int h = 0; h < 2; ++h)
#pragma unroll
                for (int i = 0; i < 2; ++i) v2[h][i] = last ? vAn[h][i] : vA[h][i];
            PG8_LDB(B0, 0, 0); PG8_SCHED; PG8_LDA(At, 0, 0); PG8_STAGE(PG8_SA(1, 1), a1, vA[1]);
            PG8_WAIT_L(8); PG8_BAR; PG8_WAIT_L(0); PG8_MMA(0, 0, At, B0); PG8_BAR; PG8_SCHED;
            PG8_LDB(B1, 0, 1); PG8_STAGE(PG8_SB(0, 0), b2, voffB);
            PG8_BAR; PG8_WAIT_L(0); PG8_MMA(0, 1, At, B1); PG8_BAR;
            PG8_LDA(At, 0, 1); PG8_STAGE(PG8_SA(0, 0), a2, v2[0]);
            PG8_BAR; PG8_WAIT_L(0); PG8_MMA(1, 0, At, B0); PG8_BAR; PG8_SCHED;
            PG8_STAGE(PG8_SB(0, 1), b2 + hstepB, voffB);
            PG8_WAIT_V(6); PG8_BAR; PG8_MMA(1, 1, At, B1); PG8_BAR;
            PG8_LDB(B0, 1, 0); PG8_SCHED; PG8_LDA(At, 1, 0); PG8_STAGE(PG8_SA(0, 1), a2, v2[1]);
            PG8_WAIT_L(8); PG8_BAR; PG8_WAIT_L(0); PG8_MMA(0, 0, At, B0); PG8_BAR; PG8_SCHED;
            PG8_LDB(B1, 1, 1); PG8_STAGE(PG8_SB(1, 0), b3, voffB);
            PG8_BAR; PG8_WAIT_L(0); PG8_MMA(0, 1, At, B1); PG8_BAR;
            PG8_LDA(At, 1, 1); PG8_STAGE(PG8_SA(1, 0), a3, v2[0]);
            PG8_BAR; PG8_WAIT_L(0); PG8_MMA(1, 0, At, B0); PG8_BAR; PG8_SCHED;
            PG8_STAGE(PG8_SB(1, 1), b3 + hstepB, voffB);
            PG8_WAIT_V(6); PG8_BAR; PG8_MMA(1, 1, At, B1); PG8_BAR;
        }
        if (prof) { const unsigned long long t = __builtin_amdgcn_s_memrealtime(); t_k += t - t_mark; t_mark = t; }
        if constexpr (FP8) asm volatile("s_nop 15\n\ts_nop 15" ::: "memory");
        E(acc, cur, wr, wc, fr, fq);
        if (prof) { asm volatile("s_waitcnt vmcnt(0)" ::: "memory"); const unsigned long long t = __builtin_amdgcn_s_memrealtime(); t_e += t - t_mark; t_mark = t; }
        if (!has_next) break;
#pragma unroll
        for (int a = 0; a < 2; ++a)
#pragma unroll
            for (int b = 0; b < 2; ++b)
#pragma unroll
                for (int m = 0; m < 4; ++m)
#pragma unroll
                    for (int n = 0; n < 2; ++n) acc[a][b][m][n] = (f32x4){0.f, 0.f, 0.f, 0.f};
        cur = nxt; cA = nA; cB = nB; ++ui;
#pragma unroll
        for (int h = 0; h < 2; ++h)
#pragma unroll
            for (int i = 0; i < 2; ++i) vA[h][i] = vAn[h][i];
    }
    PG8_WAIT_V(0);
    if (wr == 0) PG8_BAR;
    PG8_BAR;
    if (prof && blockIdx.x == 0 && tid == 0) { prof[0] = t_k; prof[1] = t_e; prof[2] = __builtin_amdgcn_s_memrealtime() - t_begin; }
#undef PG8_SA
#undef PG8_SB
#undef PG8_STAGE
#undef PG8_LDA
#undef PG8_LDB
#undef PG8_MMA
#undef PG8_WAIT_V
#undef PG8_WAIT_L
#undef PG8_BAR
#undef PG8_SCHED
#undef PG8_VOFFA
}

__device__ __forceinline__ bool static_tile(int nM, int nN, int G, int c, int i, int& pm, int& pn) {
    const int nwg = nM * nN; const long L = (long)i * G + c; if (L >= nwg) return false;
    int wgid = (int)L; { const int q = nwg / NXCD, r = nwg % NXCD, xcd = wgid % NXCD, off = wgid / NXCD; wgid = (xcd < r ? xcd * (q + 1) : r * (q + 1) + (xcd - r) * q) + off; }
    const int nig = WGM * nN, gid = wgid / nig, fm = gid * WGM, gsz = (nM - fm) < WGM ? (nM - fm) : WGM;
    pm = fm + ((wgid % nig) % gsz); pn = (wgid % nig) / gsz; return true;
}
}

struct SchedIn {
    struct U { int pm, pn; };
    const char* A; const char* B; int lda, ldb, nt, G, c;
    __device__ __forceinline__ bool next(int i, U& u) const { int j; const bool ok = pg8::static_tile(NP / 256, 14, G, c, i, u.pm, j); u.pn = (j < 6) ? 2 + j : 10 + j; return ok; }
    __device__ __forceinline__ int nt_u(const U&) const { return nt; }
    __device__ __forceinline__ const char* a_base(const U&) const { return A; }
    __device__ __forceinline__ unsigned a_row(const U& u, int r) const { return (unsigned)(u.pm * 256 + r); }
    __device__ __forceinline__ const char* b_base(const U& u) const { return B + (size_t)u.pn * 256 * ldb * 2; }
};
struct SchedIn8 {
    typedef SchedIn::U U;
    const char* A; const char* B; int lda, ldb, nt, G, c;
    __device__ __forceinline__ bool next(int i, U& u) const {
        if (i < 8) { const bool ok = pg8::static_tile(NS / 256, 32, G, c, i, u.pm, u.pn); u.pm += NP / 256; return ok; }
        int e; if (c < 224) { if (i > 8) return false; e = c; } else { if (i > 9) return false; e = 224 + 2 * (c - 224) + (i - 8); }
        if (e >= 288) return false;
        const int j = e >> 4; u.pm = e & 15; u.pn = (j < 2) ? j : (j < 10) ? 6 + j : 14 + j; return true; }
    __device__ __forceinline__ int nt_u(const U&) const { return nt; }
    __device__ __forceinline__ const char* a_base(const U&) const { return A; }
    __device__ __forceinline__ unsigned a_row(const U& u, int r) const { return (unsigned)(u.pm * 256 + r); }
    __device__ __forceinline__ const char* b_base(const U& u) const { return B + (size_t)u.pn * 256 * ldb; }
};
struct EpiIn {
    static constexpr bool HAS_MID = false;
    unsigned char* ws; float* out; const float* rope; float osc;
    __device__ __forceinline__ void operator()(const f32x4 (&acc)[2][2][4][2], const SchedIn::U& u, int wr, int wc, int fr, int fq) const {
        const int pn = u.pn; int kind, t0, width; size_t off;
        if (pn < 2) { kind = 0; t0 = 0; width = 512; off = WS_QA; } else if (pn < 4) { kind = 1; t0 = 2; width = 512; off = WS_KA; }
        else if (pn < 8) { kind = 1; t0 = 4; width = 1024; off = WS_VA; } else if (pn < 12) { kind = 2; t0 = 8; width = 1024; off = WS_RA; }
        else if (pn < 16) { kind = 3; t0 = 12; width = 1024; off = WS_QD; } else if (pn < 20) { kind = 4; t0 = 16; width = 1024; off = WS_KD; }
        else if (pn < 24) { kind = 5; t0 = 20; width = 1024; off = WS_VD; } else if (pn < 28) { kind = 6; t0 = 24; width = 1024; off = WS_GA; }
        else { kind = 6; t0 = 28; width = 1024; off = WS_GB; }
        bf16_t* base = (bf16_t*)(ws + off);
        const int row0 = u.pm * 256 + wr * 64 + fr, col0 = (pn - t0) * 256 + wc * 32 + 8 * fq;
        const bool prompt = u.pm < 16;
        const bool rope_on = (kind == 3 || kind == 4) && !prompt;
        const float sgn = (fq < 2) ? -1.f : 1.f;
#pragma unroll
        for (int ai = 0; ai < 2; ++ai)
#pragma unroll
            for (int m = 0; m < 4; ++m) {
                const int row = row0 + ai * 128 + m * 16;
                bf16_t* rowp = base + (size_t)row * width + col0;
                f32x4 cs0, cs1, sn0, sn1;
                if (rope_on) {
                    const int l = (row - NP) & 2047; const int pos = (wc & 1) ? (l & 63) : (l >> 6);
                    const float* tb = rope + ((wc & 1) ? 1024 : 0) + pos * 16 + 8 * (fq & 1);
                    const int so = (wc & 1) ? 1024 : 512;
                    cs0 = *(const f32x4*)tb; cs1 = *(const f32x4*)(tb + 4); sn0 = *(const f32x4*)(tb + so); sn1 = *(const f32x4*)(tb + so + 4);
                }
#pragma unroll
                for (int bj = 0; bj < 2; ++bj) {
                    f32x4 v0 = acc[ai][bj][m][0] * osc, v1 = acc[ai][bj][m][1] * osc;
                    if (kind == 0) { v0 = v0 * 0.08838834764831845f; v1 = v1 * 0.08838834764831845f; }
                    else if (kind == 2) {
#pragma unroll
                        for (int j = 0; j < 4; ++j) { v0[j] = siluf_(v0[j]); v1[j] = siluf_(v1[j]); } }
                    else if (kind == 6) {
#pragma unroll
                        for (int j = 0; j < 4; ++j) { v0[j] = sigmoidf_(v0[j]); v1[j] = sigmoidf_(v1[j]); } }
                    if ((kind == 4 || kind == 5) && prompt) {
                        float* o32 = out + (kind == 4 ? O_NK : O_NV) + (size_t)row * 1024 + col0 + bj * 128;
                        *(f32x4*)o32 = v0; *(f32x4*)(o32 + 4) = v1;
                    }
                    if (rope_on) {
                        f32x4 p0, p1;
#pragma unroll
                        for (int j = 0; j < 4; ++j) {
                            const auto ra = __builtin_amdgcn_permlane32_swap(__float_as_uint(v0[j]), __float_as_uint(v0[j]), false, false);
                            const auto rb = __builtin_amdgcn_permlane32_swap(__float_as_uint(v1[j]), __float_as_uint(v1[j]), false, false);
                            p0[j] = __uint_as_float(fq >= 2 ? ra[0] : ra[1]); p1[j] = __uint_as_float(fq >= 2 ? rb[0] : rb[1]); }
                        v0 = v0 * cs0 + p0 * sn0 * sgn; v1 = v1 * cs1 + p1 * sn1 * sgn;
                    }
                    u32x4 w; w.x = cvt_pk_bf16(v0[0], v0[1]); w.y = cvt_pk_bf16(v0[2], v0[3]); w.z = cvt_pk_bf16(v1[0], v1[1]); w.w = cvt_pk_bf16(v1[2], v1[3]);
                    *(u32x4*)(rowp + bj * 128) = w;
                }
            }
    }
};


namespace att {
constexpr float SCALE = 0.125f;
constexpr float THR = 8.f;
constexpr int SHM_V = 64 * 128 * 2, SHM_K = 64 * 128 * 2;
#define KSWZ(row, colB) ((row) * 256 + ((colB) ^ (((row) & 7) << 4)))
#define SBAR() __builtin_amdgcn_sched_barrier(0)
__device__ __forceinline__ int crow(int r, int hi) { return (r & 3) + 8 * (r >> 2) + 4 * hi; }
__device__ __forceinline__ void partialSM(f32x16& p0, f32x16& p1, float& m_reg, float& mn, float& alpha) {
  constexpr float C = SCALE * 1.4426950408889634f;
  float pmax = p0[0];
#pragma unroll
  for (int r = 1; r < 16; ++r) pmax = fmaxf(pmax, p0[r]);
#pragma unroll
  for (int r = 0; r < 16; ++r) pmax = fmaxf(pmax, p1[r]);
  { auto rr = __builtin_amdgcn_permlane32_swap(__float_as_uint(pmax), __float_as_uint(pmax), false, false);
    pmax = fmaxf(__uint_as_float(rr[0]), __uint_as_float(rr[1])); }
  if (__builtin_expect(__all(pmax - m_reg <= THR / SCALE), 1)) { mn = m_reg; alpha = 1.f; }
  else { mn = fmaxf(m_reg, pmax); alpha = __builtin_amdgcn_exp2f((m_reg - mn) * C); m_reg = mn; }
  const float mnC = -mn * C;
#pragma unroll
  for (int r = 0; r < 16; ++r) p0[r] = fmaf(p0[r], C, mnC);
#pragma unroll
  for (int r = 0; r < 16; ++r) p1[r] = fmaf(p1[r], C, mnC);
#pragma unroll
  for (int r = 0; r < 16; ++r) p0[r] = __builtin_amdgcn_exp2f(p0[r]);
}
__device__ __forceinline__ void finishSM(f32x16& p0, f32x16& p1, float alpha, float& l_reg, bf16x8& pa0, bf16x8& pa1, bf16x8& pa2, bf16x8& pa3) {
#pragma unroll
  for (int r = 0; r < 16; ++r) p1[r] = __builtin_amdgcn_exp2f(p1[r]);
  float ps = 0;
#pragma unroll
  for (int r = 0; r < 16; ++r) ps += p0[r];
#pragma unroll
  for (int r = 0; r < 16; ++r) ps += p1[r];
  { auto rr = __builtin_amdgcn_permlane32_swap(__float_as_uint(ps), __float_as_uint(ps), false, false);
    ps = __uint_as_float(rr[0]) + __uint_as_float(rr[1]); }
  l_reg = l_reg * alpha + ps;
#define PK4(P, BASE, OUT) do { unsigned a0 = cvt_pk_bf16(P[BASE + 0], P[BASE + 1]), a1 = cvt_pk_bf16(P[BASE + 2], P[BASE + 3]);   \
    unsigned b0 = cvt_pk_bf16(P[BASE + 4], P[BASE + 5]), b1 = cvt_pk_bf16(P[BASE + 6], P[BASE + 7]);                              \
    auto r0 = __builtin_amdgcn_permlane32_swap(a0, b0, false, false); auto r1 = __builtin_amdgcn_permlane32_swap(a1, b1, false, false); \
    u32x4 w = {r0[0], r1[0], r0[1], r1[1]}; OUT = __builtin_bit_cast(bf16x8, w); } while (0)
  PK4(p0, 0, pa0); PK4(p0, 8, pa1); PK4(p1, 0, pa2); PK4(p1, 8, pa3);
#undef PK4
}
__device__ __forceinline__ void qkt(f32x16& p0, f32x16& p1, const LAS char* Ks, const bf16x8* qr, int r32, int hi, int comp) {
#pragma unroll
  for (int r = 0; r < 16; ++r) { p0[r] = 0.f; p1[r] = 0.f; }
#pragma unroll
  for (int d0 = 0; d0 < 4; ++d0) { const int cb = (comp * 64 + d0 * 16 + hi * 8) * 2;
    const bf16x8 b0 = *(const LAS bf16x8*)(Ks + KSWZ(r32, cb));
    const bf16x8 b1 = *(const LAS bf16x8*)(Ks + KSWZ(32 + r32, cb));
    p0 = __builtin_amdgcn_mfma_f32_32x32x16_bf16(b0, qr[d0], p0, 0, 0, 0);
    p1 = __builtin_amdgcn_mfma_f32_32x32x16_bf16(b1, qr[d0], p1, 0, 0, 0); }
}
__device__ __forceinline__ int v_st(int k, int c) { const int kk = (k & ~0xC) | ((k & 4) << 1) | ((k & 8) >> 1); return ((kk >> 3) * 4 + (c >> 5)) * 512 + ((kk & 7) * 32 + (c & 31)) * 2; }
__device__ __forceinline__ int v_rd_base(int lane) { return ((lane & 3) << 3) | (((lane >> 2) & 3) << 6) | (((lane >> 4) & 1) << 5) | (((lane >> 5) & 1) << 8); }
constexpr int v_rd_off(int d0, int ks, int half) { return d0 * 512 + ks * 4096 + half * 2048; }
template <int OFF> __device__ __forceinline__ s16x4 tr_read(int vb) {
  s16x4 r; asm volatile("ds_read_b64_tr_b16 %0, %1 offset:%2" : "=&v"(r) : "v"(vb), "i"(OFF) : "memory"); return r;
}
template <int D0> __device__ __forceinline__ void pv_one(f32x16& od, int vb, bf16x8 pa0, bf16x8 pa1, bf16x8 pa2, bf16x8 pa3) {
  const s16x4 l0 = tr_read<v_rd_off(D0, 0, 0)>(vb), h0 = tr_read<v_rd_off(D0, 0, 1)>(vb), l1 = tr_read<v_rd_off(D0, 1, 0)>(vb), h1 = tr_read<v_rd_off(D0, 1, 1)>(vb);
  const s16x4 l2 = tr_read<v_rd_off(D0, 2, 0)>(vb), h2 = tr_read<v_rd_off(D0, 2, 1)>(vb), l3 = tr_read<v_rd_off(D0, 3, 0)>(vb), h3 = tr_read<v_rd_off(D0, 3, 1)>(vb);
  asm volatile("s_waitcnt lgkmcnt(0)" ::: "memory"); SBAR();
#define PK(L, H) (bf16x8){L[0], L[1], L[2], L[3], H[0], H[1], H[2], H[3]}
  od = __builtin_amdgcn_mfma_f32_32x32x16_bf16(pa0, PK(l0, h0), od, 0, 0, 0);
  od = __builtin_amdgcn_mfma_f32_32x32x16_bf16(pa1, PK(l1, h1), od, 0, 0, 0);
  od = __builtin_amdgcn_mfma_f32_32x32x16_bf16(pa2, PK(l2, h2), od, 0, 0, 0);
  od = __builtin_amdgcn_mfma_f32_32x32x16_bf16(pa3, PK(l3, h3), od, 0, 0, 0);
#undef PK
}
__device__ __forceinline__ void pv_d0(f32x16* o, int vb, bf16x8 pa0, bf16x8 pa1, bf16x8 pa2, bf16x8 pa3) {
  pv_one<0>(o[0], vb, pa0, pa1, pa2, pa3); pv_one<1>(o[1], vb, pa0, pa1, pa2, pa3); pv_one<2>(o[2], vb, pa0, pa1, pa2, pa3); pv_one<3>(o[3], vb, pa0, pa1, pa2, pa3);
}

struct Unit { const bf16_t* Q; const bf16_t* K0; const bf16_t* V0; const bf16_t* K1; const bf16_t* V1; unsigned char* O; int nt0, NT; };

__device__ __forceinline__ void unit_body(const Unit& U, LAS char* lds, float lam, const float* __restrict__ subg, const int tid) {
  constexpr int LD = 1024;
  const int wid = tid >> 6, lane = tid & 63, r32 = lane & 31, hi = lane >> 5, qs = wid >> 1, comp = wid & 1;
  LAS char* V_lds = lds; LAS char* K_lds = lds + 2 * SHM_V;
  LAS float* wsf = (LAS float*)(lds + 2 * SHM_V + 2 * SHM_K) + wid * 64; LAS float* li_l = wsf; LAS float* al_l = wsf + 32;
  float m_reg = -1e30f, l_reg = 0; f32x16 o[4]; bf16x8 qr[4];
#pragma unroll
  for (int d = 0; d < 4; ++d)
#pragma unroll
    for (int r = 0; r < 16; ++r) o[d][r] = 0.f;
  const bf16_t* Qw = U.Q + (size_t)(qs * 32 + r32) * LD + comp * 64 + hi * 8;
#pragma unroll
  for (int d0 = 0; d0 < 4; ++d0) qr[d0] = *(const bf16x8*)(Qw + d0 * 16);
  const int sr = tid >> 4, sc = (tid & 15) * 8, vst0 = v_st(sr, sc), vst1 = v_st(32 + sr, sc);
  const int vb0 = (int)(uintptr_t)V_lds + v_rd_base(lane);
  const unsigned so0 = (unsigned)(sr * LD + sc) * 2u, so1 = (unsigned)((32 + sr) * LD + sc) * 2u;
  struct { bf16x8 vs0, vs1, ks0, ks1; } sr_[2];
#define TILE_K(t) (((t) < U.nt0) ? U.K0 + (size_t)(t) * 64 * LD : U.K1 + (size_t)((t) - U.nt0) * 64 * LD)
#define TILE_V(t) (((t) < U.nt0) ? U.V0 + (size_t)(t) * 64 * LD : U.V1 + (size_t)((t) - U.nt0) * 64 * LD)
#define SLOAD(i, t) do { const char* _kb = (const char*)TILE_K(t); const char* _vb = (const char*)TILE_V(t); \
    sr_[i].vs0 = *(const bf16x8*)(_vb + so0); sr_[i].vs1 = *(const bf16x8*)(_vb + so1); \
    sr_[i].ks0 = *(const bf16x8*)(_kb + so0); sr_[i].ks1 = *(const bf16x8*)(_kb + so1); } while (0)
#define SWRITE(b, i) do { *(LAS bf16x8*)(V_lds + (b) * SHM_V + vst0) = sr_[i].vs0; *(LAS bf16x8*)(V_lds + (b) * SHM_V + vst1) = sr_[i].vs1; const int kc = sc * 2; \
    *(LAS bf16x8*)(K_lds + (b) * SHM_K + KSWZ(sr, kc)) = sr_[i].ks0; *(LAS bf16x8*)(K_lds + (b) * SHM_K + KSWZ(32 + sr, kc)) = sr_[i].ks1; } while (0)
#define SWAIT() asm volatile("s_waitcnt vmcnt(4)" ::: "memory")
#define RESC(a) do { if (__any((a) < 1.f)) { if (hi == 0) al_l[r32] = (a); asm volatile("s_waitcnt lgkmcnt(0)" ::: "memory"); \
    _Pragma("unroll") for (int d = 0; d < 4; ++d) _Pragma("unroll") for (int r = 0; r < 16; ++r) o[d][r] *= al_l[crow(r, hi)]; } } while (0)
  f32x16 pA0, pA1, pB0, pB1; float mnA, mnB, alA, alB; bf16x8 pa0, pa1, pa2, pa3; const int NT = U.NT;
  constexpr int SE = 0, SO = 1;
  SLOAD(SE, 0); asm volatile("s_waitcnt vmcnt(0)" ::: "memory"); SWRITE(0, SE); __syncthreads();
  qkt(pA0, pA1, K_lds, qr, r32, hi, comp); partialSM(pA0, pA1, m_reg, mnA, alA);
  SLOAD(SO, 1); if (2 < NT) SLOAD(SE, 2);
  SWAIT(); SWRITE(1, SO); __syncthreads();
  for (int j = 1; j + 1 < NT; j += 2) {
    SBAR(); qkt(pB0, pB1, K_lds + SHM_K, qr, r32, hi, comp);
    finishSM(pA0, pA1, alA, l_reg, pa0, pa1, pa2, pa3); SBAR();
    SLOAD(SO, j + 2); SBAR();
    pv_d0(o, vb0, pa0, pa1, pa2, pa3); partialSM(pB0, pB1, m_reg, mnB, alB);
    __syncthreads(); SWAIT(); SWRITE(0, SE);
    RESC(alB); __syncthreads();
    SBAR(); qkt(pA0, pA1, K_lds, qr, r32, hi, comp);
    finishSM(pB0, pB1, alB, l_reg, pa0, pa1, pa2, pa3); SBAR();
    if (j + 3 < NT) SLOAD(SE, j + 3); SBAR();
    pv_d0(o, vb0 + SHM_V, pa0, pa1, pa2, pa3); partialSM(pA0, pA1, m_reg, mnA, alA);
    __syncthreads(); SWAIT(); SWRITE(1, SO);
    RESC(alA); __syncthreads();
  }
  SBAR(); qkt(pB0, pB1, K_lds + SHM_K, qr, r32, hi, comp);
  finishSM(pA0, pA1, alA, l_reg, pa0, pa1, pa2, pa3); SBAR();
  pv_d0(o, vb0, pa0, pa1, pa2, pa3); partialSM(pB0, pB1, m_reg, mnB, alB);
  __syncthreads(); RESC(alB);
  finishSM(pB0, pB1, alB, l_reg, pa0, pa1, pa2, pa3); SBAR();
  pv_d0(o, vb0 + SHM_V, pa0, pa1, pa2, pa3);
  if (hi == 0) li_l[r32] = l_reg; asm volatile("s_waitcnt lgkmcnt(0)" ::: "memory");
  int lane_e = lane; asm volatile("" : "+v"(lane_e));
#define lane lane_e
#define r32 (lane_e & 31)
#define hi (lane_e >> 5)
  float rli[16];
#pragma unroll
  for (int r = 0; r < 16; ++r) rli[r] = 1.0f / li_l[crow(r, hi)];
  __syncthreads();
  LAS float* X = (LAS float*)lds + qs * 4096;
  if (comp == 1) {
#pragma unroll
    for (int d = 0; d < 4; ++d)
#pragma unroll
      for (int r = 0; r < 16; ++r) X[(d * 16 + r) * 64 + lane] = o[d][r] * rli[r] * lam;
  }
  __syncthreads();
  if (comp == 0) {
    float ss[16];
#pragma unroll
    for (int r = 0; r < 16; ++r) ss[r] = 0.f;
#pragma unroll
    for (int d = 0; d < 4; ++d)
#pragma unroll
      for (int r = 0; r < 16; ++r) { o[d][r] = o[d][r] * rli[r] - X[(d * 16 + r) * 64 + lane]; ss[r] += o[d][r] * o[d][r]; }
#pragma unroll
    for (int r = 0; r < 16; ++r) {
#pragma unroll
      for (int of = 1; of < 32; of <<= 1) ss[r] += __shfl_xor(ss[r], of);
      ss[r] = 0.8f / sqrtf(ss[r] * (1.f / 128.f) + LN_EPS);
    }
    LAS unsigned char* OT = (LAS unsigned char*)lds + 73728;
    float gg[4];
#pragma unroll
    for (int d = 0; d < 4; ++d) gg[d] = subg[d * 32 + r32];
#pragma unroll
    for (int r = 0; r < 16; ++r)
      *(LAS unsigned*)(OT + (qs * 32 + crow(r, hi)) * 128 + r32 * 4) = pk4_fp8(o[0][r] * ss[r] * gg[0], o[1][r] * ss[r] * gg[1], o[2][r] * ss[r] * gg[2], o[3][r] * ss[r] * gg[3]);
  }
  __syncthreads();
#undef lane
#undef r32
#undef hi
  int t2 = tid; asm volatile("" : "+v"(t2));
#pragma unroll
  for (int i = 0; i < 2; ++i) { const int idx = t2 + 512 * i, row = idx >> 3, c16 = idx & 7;
    *(u32x4*)(U.O + (size_t)row * 2048 + c16 * 16) = *(const LAS u32x4*)((LAS unsigned char*)lds + 73728 + row * 128 + c16 * 16); }
  __syncthreads();
#undef TILE_K
#undef TILE_V
#undef SLOAD
#undef SWRITE
#undef SWAIT
#undef RESC
}
}

namespace gla {
constexpr int G_QE = 0, G_KE = 17408, G_KDT = 34816, G_VT = 53248, G_AF = 90112, G_TOT = 94208, G_EBL = 96256, G_WA = 96768, G_VR = 105472;
__device__ __forceinline__ int crow(int r, int hi) { return (r & 3) + 8 * (r >> 2) + 4 * hi; }
__device__ __forceinline__ int qe_addr(int row, int pos) { return row * 272 + pos * 2; }
__device__ __forceinline__ int t_addr(int row, int chunk) { return row * 144 + chunk * 16; }
__device__ __forceinline__ constexpr int swz23(int x) { return (x & ~12) | ((x & 4) << 1) | ((x & 8) >> 1); }
__device__ __forceinline__ bf16x8 pack8(const f32x16& x, int s) {
  u32x4 p; p.x = cvt_pk_bf16(x[8 * s], x[8 * s + 1]); p.y = cvt_pk_bf16(x[8 * s + 2], x[8 * s + 3]); p.z = cvt_pk_bf16(x[8 * s + 4], x[8 * s + 5]); p.w = cvt_pk_bf16(x[8 * s + 6], x[8 * s + 7]);
  return __builtin_bit_cast(bf16x8, p);
}
#define GMFMA(a, b, c) __builtin_amdgcn_mfma_f32_32x32x16_bf16((a), (b), (c), 0, 0, 0)

__device__ __forceinline__ void chain(const Params& P, LAS char* lds, int chain_id, const int tid_in) {
  int tid = tid_in; asm volatile("" : "+v"(tid));
  const bool samp = chain_id < 64; const int cc = samp ? chain_id : chain_id - 64;
  const int b = cc >> 3, h = (cc >> 1) & 3, dir = cc & 1;
  const int L = samp ? SEQ_S : SEQ_P, nchunk = L / 64, tok0 = samp ? NP + b * SEQ_S : b * SEQ_P;
  const int w = tid >> 6, lane = tid & 63, r32 = lane & 31, hi = lane >> 5;
  const int dk = tid & 127, tg = tid >> 7, dv = tid & 255, th = tid >> 8;
  const bf16_t* QA = (const bf16_t*)(P.ws + WS_QA); const bf16_t* KA = (const bf16_t*)(P.ws + WS_KA); const bf16_t* VA = (const bf16_t*)(P.ws + WS_VA);
  const float* AFAB = (const float*)(P.ws + WS_AFAB);
  bf16_t* OUT = (bf16_t*)(P.ws + (dir ? WS_OB : WS_OF));
  const float* wal = dir ? P.in[I_WAB] : P.in[I_WAF]; const float* bal = dir ? P.in[I_BAB] : P.in[I_BAF];
  LAS float* wal_l = (LAS float*)(lds + G_WA);
  for (int i = tid; i < 17 * 128; i += NTHREADS) wal_l[i] = (i < 2048) ? wal[(i >> 7) * 512 + h * 128 + (i & 127)] : bal[h * 128 + (i & 127)];
  f32x16 St[4];
  if (samp) { const float* s0 = (dir ? P.in[I_SB] : P.in[I_SF]) + (size_t)(b * 4 + h) * 128 * 256;
#pragma unroll
    for (int kb = 0; kb < 4; ++kb)
#pragma unroll
      for (int r = 0; r < 16; ++r) St[kb][r] = s0[(size_t)(32 * kb + crow(r, hi)) * 256 + 32 * w + r32];
  } else {
#pragma unroll
    for (int kb = 0; kb < 4; ++kb)
#pragma unroll
      for (int r = 0; r < 16; ++r) St[kb][r] = 0.f;
  }
  LAS float* afl = (LAS float*)(lds + G_AF); LAS float* tot = (LAS float*)(lds + G_TOT); LAS float* ebl = (LAS float*)(lds + G_EBL);
#define TOKC(c_, i) (tok0 + (dir ? (L - 1 - (64 * (c_) + (i))) : (64 * (c_) + (i))))
  f32x4 saf = {0.f, 0.f, 0.f, 0.f}; u32x4 sq[2], sk[2], sv[4];
#define GLA_LOAD(CH) do { int t_ = tid; asm volatile("" : "+v"(t_)); \
    if (t_ < 256) { const int i = t_ >> 2, q = t_ & 3; saf = *(const f32x4*)(AFAB + (size_t)TOKC(CH, i) * 32 + dir * 16 + 4 * q); } \
    _Pragma("unroll") for (int n = 0; n < 2; ++n) { const int c = t_ + 512 * n, i = c >> 4, d0 = (c & 15) * 8; const size_t t = (size_t)TOKC(CH, i); \
      sq[n] = *(const u32x4*)(QA + t * 512 + h * 128 + d0); sk[n] = *(const u32x4*)(KA + t * 512 + h * 128 + d0); } \
    _Pragma("unroll") for (int n = 0; n < 4; ++n) { const int c = t_ + 512 * n, i = c >> 5, cq = c & 31; sv[n] = *(const u32x4*)(VA + (size_t)TOKC(CH, i) * 1024 + h * 256 + cq * 8); } } while (0)
  GLA_LOAD(0);
  for (int ch = 0; ch < nchunk; ++ch) {
#define TOK(i) TOKC(ch, i)
    int tp_ = tid; asm volatile("" : "+v"(tp_));
    const int dk = tp_ & 127, tg = tp_ >> 7, dv = tp_ & 255, th = tp_ >> 8;
    if (tp_ < 256) *((LAS f32x4*)afl + tp_) = saf;
#pragma unroll
    for (int n = 0; n < 2; ++n) { const int c = tp_ + 512 * n, i = c >> 4, d0 = (c & 15) * 8;
      const u32x4 xq = sq[n], xk = sk[n];
      const int p0 = swz23(d0 & 15) | (d0 & ~15), p1 = swz23((d0 + 4) & 15) | (d0 & ~15);
      *(LAS u32x2*)(lds + G_QE + qe_addr(i, p0)) = (u32x2){xq.x, xq.y}; *(LAS u32x2*)(lds + G_QE + qe_addr(i, p1)) = (u32x2){xq.z, xq.w};
      *(LAS u32x2*)(lds + G_KE + qe_addr(i, p0)) = (u32x2){xk.x, xk.y}; *(LAS u32x2*)(lds + G_KE + qe_addr(i, p1)) = (u32x2){xk.z, xk.w}; }
#pragma unroll
    for (int n = 0; n < 4; ++n) { const int c = tp_ + 512 * n, i = c >> 5, cq = c & 31;
      *(LAS u32x4*)(lds + G_VR + i * 528 + cq * 16) = sv[n]; }
    __syncthreads();
    float bl[16]; float run = 0.f;
    float wa[16];
#pragma unroll
    for (int r = 0; r < 16; ++r) wa[r] = wal_l[r * 128 + dk];
    const float ba = wal_l[2048 + dk];
#pragma unroll
    for (int ii = 0; ii < 16; ++ii) { const int i = 16 * tg + ii; float z = ba;
#pragma unroll
      for (int q = 0; q < 4; ++q) { const f32x4 a = *((const LAS f32x4*)afl + i * 4 + q); z += a.x * wa[4 * q] + a.y * wa[4 * q + 1] + a.z * wa[4 * q + 2] + a.w * wa[4 * q + 3]; }
      const float g = (fminf(z, 0.f) - __logf(1.0f + __expf(-fabsf(z)))) * (1.0f / 16.0f);
      run += g; bl[ii] = run; }
    tot[tg * 128 + dk] = run;
#pragma unroll
    for (int q = 0; q < 4; ++q) { const int b16 = (q >> 1) * 16, q8 = (q & 1) * 8; unsigned short e[8];
#pragma unroll
      for (int j = 0; j < 8; ++j) e[j] = *(const LAS unsigned short*)(lds + G_VR + (32 * th + b16 + swz23(q8 + j)) * 528 + dv * 2);
      u32x4 o; o.x = (unsigned)e[0] | ((unsigned)e[1] << 16); o.y = (unsigned)e[2] | ((unsigned)e[3] << 16); o.z = (unsigned)e[4] | ((unsigned)e[5] << 16); o.w = (unsigned)e[6] | ((unsigned)e[7] << 16);
      *(LAS u32x4*)(lds + G_VT + t_addr(dv, 4 * th + q)) = o; }
    __syncthreads();
    if (ch + 1 < nchunk) GLA_LOAD(ch + 1);
    const float t0 = tot[dk], t1 = tot[128 + dk], t2 = tot[256 + dk], t3 = tot[384 + dk];
    const float pre = (tg > 0 ? t0 : 0.f) + (tg > 1 ? t1 : 0.f) + (tg > 2 ? t2 : 0.f), total = (t0 + t1) + (t2 + t3);
    const float etot = __expf(total);
    if (tg == 0) ebl[dk] = etot;
    const int pdk = swz23(dk & 15) | (dk & ~15);
    unsigned short kdv[16];
#pragma unroll
    for (int ii = 0; ii < 16; ++ii) { const int i = 16 * tg + ii; const float bc = pre + bl[ii];
      LAS unsigned short* qp = (LAS unsigned short*)(lds + G_QE + qe_addr(i, pdk)); LAS unsigned short* kp = (LAS unsigned short*)(lds + G_KE + qe_addr(i, pdk));
      const float q = bf2f(*qp), k = bf2f(*kp);
      const float eb = __expf(bc), ieb = __builtin_amdgcn_rcpf(eb);
      const unsigned pq = cvt_pk_bf16(q * eb, k * ieb);
      *qp = (unsigned short)(pq & 0xffffu); *kp = (unsigned short)(pq >> 16);
      kdv[ii] = (unsigned short)(cvt_pk_bf16(k * (etot * ieb), 0.f) & 0xffffu); }
#pragma unroll
    for (int q = 0; q < 2; ++q) { u32x4 o;
      o.x = (unsigned)kdv[swz23(8 * q + 0)] | ((unsigned)kdv[swz23(8 * q + 1)] << 16); o.y = (unsigned)kdv[swz23(8 * q + 2)] | ((unsigned)kdv[swz23(8 * q + 3)] << 16);
      o.z = (unsigned)kdv[swz23(8 * q + 4)] | ((unsigned)kdv[swz23(8 * q + 5)] << 16); o.w = (unsigned)kdv[swz23(8 * q + 6)] | ((unsigned)kdv[swz23(8 * q + 7)] << 16);
      *(LAS u32x4*)(lds + G_KDT + t_addr(dk, 2 * tg + q)) = o; }
    __syncthreads();
    int tm_ = tid; asm volatile("" : "+v"(tm_));
    const int w = tm_ >> 6, lane = tm_ & 63, r32 = lane & 31, hi = lane >> 5;
    bf16x8 Sb[4][2];
#pragma unroll
    for (int kb = 0; kb < 4; ++kb) { Sb[kb][0] = pack8(St[kb], 0); Sb[kb][1] = pack8(St[kb], 1); }
    f32x16 o[2];
#pragma unroll
    for (int ib = 0; ib < 2; ++ib) {
#pragma unroll
      for (int r = 0; r < 16; ++r) o[ib][r] = 0.f;
#pragma unroll
      for (int kb = 0; kb < 4; ++kb)
#pragma unroll
        for (int s = 0; s < 2; ++s) { const bf16x8 a = *(const LAS bf16x8*)(lds + G_QE + qe_addr(32 * ib + r32, 32 * kb + 16 * s + 8 * hi)); o[ib] = GMFMA(a, Sb[kb][s], o[ib]); }
      asm volatile("" ::: "memory");
    }
    bf16x8 vf[2][2];
#pragma unroll
    for (int jb = 0; jb < 2; ++jb)
#pragma unroll
      for (int s = 0; s < 2; ++s) vf[jb][s] = *(const LAS bf16x8*)(lds + G_VT + t_addr(32 * w + r32, 4 * jb + 2 * s + hi));
#pragma unroll
    for (int blk = 0; blk < 3; ++blk) { const int jb = (blk == 2) ? 1 : 0, ib = (blk == 0) ? 0 : 1;
      f32x16 X;
#pragma unroll
      for (int r = 0; r < 16; ++r) X[r] = 0.f;
#pragma unroll
      for (int ks = 0; ks < 8; ++ks) { const bf16x8 a = *(const LAS bf16x8*)(lds + G_KE + qe_addr(32 * jb + r32, 16 * ks + 8 * hi));
        const bf16x8 bq = *(const LAS bf16x8*)(lds + G_QE + qe_addr(32 * ib + r32, 16 * ks + 8 * hi)); X = GMFMA(a, bq, X); }
      if (jb == ib) {
#pragma unroll
        for (int r = 0; r < 16; ++r) X[r] = (r32 >= crow(r, hi)) ? X[r] : 0.f; }
#pragma unroll
      for (int s = 0; s < 2; ++s) { const bf16x8 xa = pack8(X, s); o[ib] = GMFMA(xa, vf[jb][s], o[ib]); }
      asm volatile("" ::: "memory");
    }
#pragma unroll
    for (int kb = 0; kb < 4; ++kb) {
#pragma unroll
      for (int g = 0; g < 4; ++g) { const f32x4 e4 = *(const LAS f32x4*)(ebl + 32 * kb + 8 * g + 4 * hi);
        St[kb][4 * g] *= e4.x; St[kb][4 * g + 1] *= e4.y; St[kb][4 * g + 2] *= e4.z; St[kb][4 * g + 3] *= e4.w; }
#pragma unroll
      for (int jb = 0; jb < 2; ++jb)
#pragma unroll
        for (int s = 0; s < 2; ++s) { const bf16x8 a = *(const LAS bf16x8*)(lds + G_KDT + t_addr(32 * kb + r32, 4 * jb + 2 * s + hi)); St[kb] = GMFMA(a, vf[jb][s], St[kb]); }
      asm volatile("" ::: "memory");
    }
#pragma unroll
    for (int ib = 0; ib < 2; ++ib)
#pragma unroll
      for (int r = 0; r < 16; ++r) *(LAS unsigned short*)(lds + G_VR + (32 * ib + crow(r, hi)) * 528 + (32 * w + r32) * 2) = (unsigned short)(cvt_pk_bf16(o[ib][r], 0.f) & 0xffffu);
    __syncthreads();
    { int t2 = tid; asm volatile("" : "+v"(t2));
#pragma unroll
      for (int n = 0; n < 4; ++n) { const int c = t2 + 512 * n, i = c >> 5, cq = c & 31;
        *(u32x4*)(OUT + (size_t)TOK(i) * 1024 + h * 256 + cq * 8) = *(const LAS u32x4*)(lds + G_VR + i * 528 + cq * 16); } }
    __syncthreads();
#undef TOK
  }
#undef GLA_LOAD
#undef TOKC
  asm volatile("s_waitcnt vmcnt(0)" ::: "memory"); __syncthreads();
  if (tid == 0) { __builtin_amdgcn_fence(__ATOMIC_RELEASE, "agent"); asm volatile("s_waitcnt vmcnt(0)" ::: "memory");
    __hip_atomic_fetch_add((unsigned*)(P.ws + WS_CTL) + 512 + 16 * (samp ? 16 + b : b), 1u, __ATOMIC_RELAXED, __HIP_MEMORY_SCOPE_AGENT); }
  if (!samp) { float* so = P.out + (dir ? O_NB : O_NF) + (size_t)(b * 4 + h) * 128 * 256;
#pragma unroll
    for (int kb = 0; kb < 4; ++kb)
#pragma unroll
      for (int r = 0; r < 16; ++r) so[(size_t)(32 * kb + crow(r, hi)) * 256 + 32 * w + r32] = St[kb][r]; }
}
}

__device__ __forceinline__ void p4_item(Frame& F, int item) {
    const Params& P = *F.p;
    int tl_ = F.tid; asm volatile("" : "+v"(tl_)); const int p4lane = tl_ & 63, p4wave = tl_ >> 6;
    const bf16_t* OFp = (const bf16_t*)(P.ws + WS_OF); const bf16_t* OBp = (const bf16_t*)(P.ws + WS_OB); const bf16_t* RA = (const bf16_t*)(P.ws + WS_RA);
    bf16_t* OAN = (bf16_t*)(P.ws + WS_OCAT);
    const f32x4 g = *((const f32x4*)P.in[I_GLAG] + p4lane);
#pragma unroll 2
    for (int t = 0; t < 8; ++t) {
        const int m = item * 64 + t * 8 + p4wave;
        const size_t rb = (size_t)m * 1024 + 4 * p4lane;
        u32x2 a[4], b[4], r[4];
#pragma unroll
        for (int j = 0; j < 4; ++j) { a[j] = *(const u32x2*)(OFp + rb + 256 * j); b[j] = *(const u32x2*)(OBp + rb + 256 * j); r[j] = *(const u32x2*)(RA + rb + 256 * j); }
#pragma unroll
        for (int j = 0; j < 4; ++j) {
            f32x4 f; f.x = bflo(a[j].x) + bflo(b[j].x); f.y = bfhi(a[j].x) + bfhi(b[j].x); f.z = bflo(a[j].y) + bflo(b[j].y); f.w = bfhi(a[j].y) + bfhi(b[j].y);
            const float ss = wave_sum((f.x * f.x + f.y * f.y) + (f.z * f.z + f.w * f.w));
            const float rs = 1.f / sqrtf(ss * (1.f / 256.f) + LN_EPS);
            *(unsigned*)((unsigned char*)OAN + (size_t)m * 2048 + 4 * p4lane + 256 * j) = pk4_fp8(f.x * rs * g.x * bflo(r[j].x), f.y * rs * g.y * bfhi(r[j].x), f.z * rs * g.z * bflo(r[j].y), f.w * rs * g.w * bfhi(r[j].y));
        }
    }
}

constexpr int Q_GLA = 192, Q_AS = 1024, Q_AP = 256, CONV_PER = 28, CONV_P3 = (Q_AS / 8) * CONV_PER, Q_AS_EXT = Q_AS + Q_AS / 8, Q_ATT = Q_AS_EXT + Q_AP;
static_assert(CONV_P3 <= CONV_TOTAL && (CONV_TOTAL - CONV_P3) % 4 == 0, "conversion split");
__device__ __forceinline__ void p3_mixers(Frame& F, int rep) {
    const Params& P = *F.p;
    unsigned* ctr = (unsigned*)(P.ws + WS_CTL) + rep;
    LAS unsigned* slot = (LAS unsigned*)(F.lds + LDS_BYTES - 64);
#define CONV_BATCH(N) do { const int _n = (N); if (_n > 0) { if (F.tid == 0) *slot = atomicAdd(ctr + 192, (unsigned)_n); __syncthreads(); const int _b = (int)*slot; __syncthreads(); \
        conv_batch(P, F.lds, F.tid, _b, _n); } } while (0)
#define samp_chain_batch(u) (((u) < 64) ? 12 : 2)
    const float lam = ((const float*)(P.ws + WS_MOD))[9 * 6144];
    const bf16_t* QD = (const bf16_t*)(P.ws + WS_QD); const bf16_t* KD = (const bf16_t*)(P.ws + WS_KD); const bf16_t* VD = (const bf16_t*)(P.ws + WS_VD);
    const bf16_t* CK = (const bf16_t*)(P.ws + WS_CK); const bf16_t* CV = (const bf16_t*)(P.ws + WS_CV); unsigned char* ODN = (unsigned char*)(P.ws + WS_OCAT) + 1024;
    const int myx = (int)(__builtin_amdgcn_s_getreg((3 << 11) | 20) & 7u);
    for (int pass = 0; pass < 2; ++pass) {
    for (;;) {
        if (F.tid == 0) *slot = atomicAdd(ctr + 2 * pass, 1u);
        __syncthreads();
        const int u = (int)*slot;
        __syncthreads();
        if (u >= (pass ? Q_GLA - 64 : 64)) break;
        gla::chain(P, (LAS char*)F.lds, pass ? 64 + u : u, F.tid);
    }
    int xs = 0;
    for (;;) {
        const int qx = (myx + xs) & 7;
        if (F.tid == 0) *slot = atomicAdd(ctr + 1024 + 16 * qx + 2 * pass, 1u);
        __syncthreads();
        int u = (int)*slot;
        __syncthreads();
        if (u >= (pass ? Q_AP / 8 : Q_AS_EXT / 8)) { if (++xs >= 8) break; continue; }
        if (!pass) {
            if (u < 16 * 7) { const int g7 = u / 7, r7 = u - 7 * g7;
                if (r7 == 0) { conv_batch(P, F.lds, F.tid, (qx * 16 + g7) * CONV_PER, CONV_PER); continue; }
                u = 6 * g7 + r7 - 1; }
            else u -= 16;
            u += qx * (Q_AS / 8); }
        else u += Q_AS + qx * (Q_AP / 8);
        att::Unit U;
        if (u < Q_AS) {
            const int b = u >> 7, h = (u >> 4) & 7, qb = u & 15; const size_t tok0 = NP + (size_t)b * SEQ_S;
            U.Q = QD + (tok0 + qb * 128) * 1024 + h * 128; U.K0 = KD + tok0 * 1024 + h * 128; U.V0 = VD + tok0 * 1024 + h * 128;
            U.K1 = CK + (size_t)b * PAST * 1024 + h * 128; U.V1 = CV + (size_t)b * PAST * 1024 + h * 128; U.O = ODN + (tok0 + qb * 128) * 2048 + h * 128; U.nt0 = 32; U.NT = 36;
        } else {
            const int a = u - Q_AS, b = a >> 4, h = (a >> 1) & 7, qb = a & 1; const size_t tok0 = (size_t)b * SEQ_P;
            U.Q = QD + (tok0 + qb * 128) * 1024 + h * 128; U.K0 = KD + tok0 * 1024 + h * 128; U.V0 = VD + tok0 * 1024 + h * 128;
            U.K1 = U.K0; U.V1 = U.V0; U.O = ODN + (tok0 + qb * 128) * 2048 + h * 128; U.nt0 = 4; U.NT = 4;
        }
        att::unit_body(U, (LAS char*)F.lds, lam, P.in[I_SUBG], F.tid);
    }
    }
    for (;;) {
        if (F.tid == 0) *slot = atomicAdd(ctr + 128, 1u);
        __syncthreads();
        int it = (int)*slot;
        __syncthreads();
        if (it >= NTOK / 64) break;
        it = (it < 256) ? it + 64 : it - 256;
        const int bidx = (it < 64) ? (it >> 2) : 16 + ((it - 64) >> 5);
        if (F.tid == 0) {
            unsigned* c = (unsigned*)(P.ws + WS_CTL) + 512 + 16 * bidx; unsigned spins = 0;
            while (__hip_atomic_load(c, __ATOMIC_RELAXED, __HIP_MEMORY_SCOPE_AGENT) < 8u) { __builtin_amdgcn_s_sleep(8); if (++spins > (1u << 24)) break; }
            __builtin_amdgcn_fence(__ATOMIC_ACQUIRE, "agent"); asm volatile("s_waitcnt vmcnt(0)" ::: "memory");
        }
        __syncthreads();
        p4_item(F, it);
    }
#undef CONV_BATCH
#undef samp_chain_batch
}

struct SchedMrg {
    struct U { int pm, pn, half; };
    const char* A; const char* B; int lda, ldb, nt, G, c;
    __device__ __forceinline__ bool next(int i, U& u) const { const int L = c + G * i; if (L >= 384) return false;
        if (L < 256) { u.pm = L >> 2; u.pn = L & 3; u.half = -1; } else { const int s = L - 256, tl = 256 + (s >> 1); u.pm = tl >> 2; u.pn = tl & 3; u.half = s & 1; } return true; }
    __device__ __forceinline__ int nt_u(const U& u) const { return (u.half < 0) ? nt : nt / 2; }
    __device__ __forceinline__ const char* a_base(const U& u) const { return A + ((u.half == 1) ? 1024 : 0); }
    __device__ __forceinline__ unsigned a_row(const U& u, int r) const { return (unsigned)(u.pm * 256 + r); }
    __device__ __forceinline__ const char* b_base(const U& u) const { return B + (size_t)u.pn * 256 * ldb + ((u.half == 1) ? 1024 : 0); }
};
struct EpiMrg {
    static constexpr bool HAS_MID = true; static constexpr int MID_T = 8;
    const bf16_t* GA; const bf16_t* GB; bf16_t* M; unsigned char* WSB;
    __device__ __forceinline__ void mid(f32x4 (&acc)[2][2][4][2], const SchedMrg::U& u, int wr, int wc, int fr, int fq) const {
        asm volatile("" : "+v"(fr), "+v"(fq));
        const int row0 = u.pm * 256 + wr * 64 + fr, col0 = u.pn * 256 + wc * 32 + 8 * fq;
#pragma unroll
        for (int ai = 0; ai < 2; ++ai)
#pragma unroll
            for (int m = 0; m < 4; ++m) {
#pragma unroll
                for (int bj = 0; bj < 2; ++bj) {
                    const size_t off = (size_t)(row0 + ai * 128 + m * 16) * 1024 + col0 + bj * 128;
                    const u32x4 a = *(const u32x4*)(GA + off), b = *(const u32x4*)(GB + off);
#define RC(x) __builtin_amdgcn_rcpf(fmaxf((x), 1e-20f))
                    const f32x4 r0 = {bflo(a.x) * RC(bflo(b.x)), bfhi(a.x) * RC(bfhi(b.x)), bflo(a.y) * RC(bflo(b.y)), bfhi(a.y) * RC(bfhi(b.y))};
                    const f32x4 r1 = {bflo(a.z) * RC(bflo(b.z)), bfhi(a.z) * RC(bfhi(b.z)), bflo(a.w) * RC(bflo(b.w)), bfhi(a.w) * RC(bfhi(b.w))};
#undef RC
                    acc[ai][bj][m][0] = acc[ai][bj][m][0] * r0; acc[ai][bj][m][1] = acc[ai][bj][m][1] * r1;
                }
                asm volatile("" ::: "memory");
            }
    }
    __device__ __forceinline__ void operator()(const f32x4 (&acc)[2][2][4][2], const SchedMrg::U& u, int wr, int wc, int fr, int fq) const {
        const int row0 = u.pm * 256 + wr * 64 + fr, col0 = u.pn * 256 + wc * 32 + 8 * fq;
        const size_t goff = (u.half == 0) ? 0 : (size_t)(GB - GA);
        const size_t obase = (u.half < 0) ? WS_MRG : WS_MRG2 + (size_t)u.half * 1024 - (size_t)ROW_LO * 2048; const size_t old = (u.half < 0) ? 1024 : 2048;
#pragma unroll
        for (int ai = 0; ai < 2; ++ai)
#pragma unroll
            for (int m = 0; m < 4; ++m)
#pragma unroll
                for (int bj = 0; bj < 2; ++bj) {
                    const int row = row0 + ai * 128 + m * 16, col = col0 + bj * 128;
                    const size_t off = (size_t)row * 1024 + col;
                    const u32x4 g = *(const u32x4*)(GA + goff + off);
                    const f32x4 t0 = acc[ai][bj][m][0] * (f32x4){bflo(g.x), bfhi(g.x), bflo(g.y), bfhi(g.y)}, t1 = acc[ai][bj][m][1] * (f32x4){bflo(g.z), bfhi(g.z), bflo(g.w), bfhi(g.w)};
                    u32x2 w; w.x = pk4_fp8(t0.x * (S_MRG / S_WP), t0.y * (S_MRG / S_WP), t0.z * (S_MRG / S_WP), t0.w * (S_MRG / S_WP)); w.y = pk4_fp8(t1.x * (S_MRG / S_WP), t1.y * (S_MRG / S_WP), t1.z * (S_MRG / S_WP), t1.w * (S_MRG / S_WP));
                    *(u32x2*)(WSB + obase + (size_t)row * old + col) = w;
                    asm volatile("" ::: "memory");
                }
    }
};

struct SchedOut {
    struct U { int pm, pn, q; };
    const char* W; const char* B; int lda, ldb, nt, G, c;
    __device__ __forceinline__ bool next(int i, U& u) const { const int L = c + G * i; if (L >= 512) return false;
        if (L < 256) { u.pm = L >> 2; u.pn = L & 3; u.q = -1; } else { const int s = L - 256, tl = 256 + (s >> 2); u.pm = tl >> 2; u.pn = tl & 3; u.q = s & 3; } return true; }
    __device__ __forceinline__ int nt_u(const U& u) const { return (u.q < 0) ? nt : nt / 2; }
    __device__ __forceinline__ const char* a_base(const U& u) const { return W + ((u.q < 0) ? WS_MRG : WS_MRG2 + (size_t)u.q * 512); }
    __device__ __forceinline__ unsigned a_row(const U& u, int r) const { return (u.q < 0) ? (unsigned)(u.pm * 256 + r) : 2u * (unsigned)(u.pm * 256 - ROW_LO + r); }
    __device__ __forceinline__ const char* b_base(const U& u) const { return B + (size_t)u.pn * 256 * ldb + ((u.q < 0) ? 0 : u.q * 512); }
};
constexpr float ALPHA = 1.189207115002721f;
struct EpiOut {
    static constexpr bool HAS_MID = false;
    bf16_t* MIX; bf16_t* MIX2;
    __device__ __forceinline__ void operator()(const f32x4 (&acc)[2][2][4][2], const SchedOut::U& u, int wr, int wc, int fr, int fq) const {
        const int row0 = u.pm * 256 + wr * 64 + fr, col0 = u.pn * 256 + wc * 32 + 8 * fq;
        unsigned char* M8 = (unsigned char*)MIX;
        const size_t pbase = (u.q <= 0) ? 0 : (size_t)((unsigned char*)MIX2 - (unsigned char*)MIX) + ((size_t)(u.q - 1) * 4096 - ROW_LO) * 1024;
#pragma unroll
        for (int ai = 0; ai < 2; ++ai)
#pragma unroll
            for (int m = 0; m < 4; ++m)
#pragma unroll
                for (int bj = 0; bj < 2; ++bj) { const f32x4 v0 = acc[ai][bj][m][0] * (S_MIX / (S_MRG * S_WP)), v1 = acc[ai][bj][m][1] * (S_MIX / (S_MRG * S_WP));
                    u32x2 w; w.x = pk4_fp8(v0.x, v0.y, v0.z, v0.w); w.y = pk4_fp8(v1.x, v1.y, v1.z, v1.w);
                    *(u32x2*)(M8 + pbase + (size_t)(row0 + ai * 128 + m * 16) * 1024 + col0 + bj * 128) = w; }
    }
};

template <class SyncF> __device__ __forceinline__ void p7_ln1_router(Frame& F, SyncF&& sync) {
    const Params& P = *F.p;
    constexpr int RS = 2064;
    LAS unsigned char* WT = F.lds;
    LAS unsigned char* HT = F.lds + 16 * RS;
    LAS f32x4* RED = (LAS f32x4*)(F.lds + 32 * RS);
    const float* mod = (const float*)(P.ws + WS_MOD); const bf16_t* MIX = (const bf16_t*)(P.ws + WS_MIX); const bf16_t* MIX2 = (const bf16_t*)(P.ws + WS_MIX2);
    bf16_t* X1B = (bf16_t*)(P.ws + WS_X1B); unsigned char* H2 = (unsigned char*)(P.ws + WS_H2); float* aff = (float*)(P.ws + WS_AFF); int* sel = (int*)(P.ws + WS_SEL);
    const int lane = F.lane, w = F.wave;
    f32x4 xv[2][4]; unsigned mv[2][4];
#define P7_LOAD(BLK) do { _Pragma("unroll") for (int rr = 0; rr < 2; ++rr) { const int m_ = (BLK) * 16 + 2 * w + rr; \
        _Pragma("unroll") for (int j = 0; j < 4; ++j) { xv[rr][j] = *((const f32x4*)xrow_ptr(P, m_) + lane + 64 * j); mv[rr][j] = *((const unsigned*)((const unsigned char*)MIX + (size_t)m_ * D) + lane + 64 * j); } } } while (0)
#define P7_LOADX(BLK) do { _Pragma("unroll") for (int rr = 0; rr < 2; ++rr) { const int m_ = (BLK) * 16 + 2 * w + rr; \
        _Pragma("unroll") for (int j = 0; j < 4; ++j) xv[rr][j] = *((const f32x4*)xrow_ptr(P, m_) + lane + 64 * j); } } while (0)
#define P7_LOADM(BLK) do { _Pragma("unroll") for (int rr = 0; rr < 2; ++rr) { const int m_ = (BLK) * 16 + 2 * w + rr; \
        _Pragma("unroll") for (int j = 0; j < 4; ++j) mv[rr][j] = *((const unsigned*)((const unsigned char*)MIX + (size_t)m_ * D) + lane + 64 * j); } } while (0)
    f32x4 lg[4], lb[4];
    sync([&]() {
    { u32x4 wv[4];
#pragma unroll
      for (int j = 0; j < 4; ++j) wv[j] = *((const u32x4*)(P.ws + WS_WRB) + F.tid + NTHREADS * j);
#pragma unroll
      for (int j = 0; j < 4; ++j) { const int idx = F.tid + NTHREADS * j; *(LAS u32x4*)(WT + (idx >> 7) * RS + (idx & 127) * 16) = wv[j]; } }
    __syncthreads();
#pragma unroll
    for (int j = 0; j < 4; ++j) { lg[j] = *((const f32x4*)P.in[I_LN1G] + lane + 64 * j); lb[j] = *((const f32x4*)P.in[I_LN1B] + lane + 64 * j); }
    if (F.vcu < NTOK / 16) P7_LOADX(F.vcu);
    });
    if (F.vcu < NTOK / 16) P7_LOADM(F.vcu);
    for (int blk = F.vcu; blk < NTOK / 16; blk += F.G) {
        const int row0 = blk * 16; const float* md = mod + mod_row(row0) * 6144;
        f32x4 mg1[4], msh[4], msc[4];
#pragma unroll
        for (int j = 0; j < 4; ++j) { mg1[j] = *((const f32x4*)(md + 2048) + lane + 64 * j); msh[j] = *((const f32x4*)(md + 3072) + lane + 64 * j); msc[j] = *((const f32x4*)(md + 4096) + lane + 64 * j); }
        f32x4 vv[2][4]; float s_[2];
        const bool extra = row0 >= ROW_LO;
#pragma unroll
        for (int rr = 0; rr < 2; ++rr) { s_[rr] = 0.f;
            unsigned ex[3][4];
            if (extra) {
#pragma unroll
                for (int p = 0; p < 3; ++p)
#pragma unroll
                    for (int j = 0; j < 4; ++j) ex[p][j] = *((const unsigned*)((const unsigned char*)MIX2 + ((size_t)p * 4096 + (row0 - ROW_LO + 2 * w + rr)) * D) + lane + 64 * j);
                asm volatile("" ::: "memory");
            }
#pragma unroll
            for (int j = 0; j < 4; ++j) {
                f32x4 mx = fp8x4_f32(mv[rr][j]);
                if (extra) {
#pragma unroll
                    for (int p = 0; p < 3; ++p) mx = mx + fp8x4_f32(ex[p][j]); }
                vv[rr][j] = xv[rr][j] * ALPHA + mg1[j] * (1.0f / S_MIX) * mx; s_[rr] += (vv[rr][j].x + vv[rr][j].y) + (vv[rr][j].z + vv[rr][j].w); } }
        asm volatile("" :: "v"(msh[0]), "v"(msh[1]), "v"(msh[2]), "v"(msh[3]), "v"(msc[0]), "v"(msc[1]), "v"(msc[2]), "v"(msc[3]));
        if (blk + F.G < NTOK / 16) P7_LOAD(blk + F.G);
#pragma unroll
        for (int rr = 0; rr < 2; ++rr) {
            const int m = row0 + 2 * w + rr;
            f32x4 v[4]; float s = s_[rr];
#pragma unroll
            for (int j = 0; j < 4; ++j) v[j] = vv[rr][j];
            float mean = wave_sum(s) * (1.f / D), s2 = 0.f;
#pragma unroll
            for (int j = 0; j < 4; ++j) { v[j] = v[j] - mean; s2 += (v[j].x * v[j].x + v[j].y * v[j].y) + (v[j].z * v[j].z + v[j].w * v[j].w); }
            float rstd = 1.f / sqrtf(wave_sum(s2) * (1.f / D) + LN_EPS);
            u32x2* xr = (u32x2*)(X1B + (size_t)m * D) + lane;
            s = 0.f;
#pragma unroll
            for (int j = 0; j < 4; ++j) { const f32x4 g = lg[j], b = lb[j];
                v[j] = v[j] * rstd * g + b; u32x2 wv; wv.x = cvt_pk_bf16(v[j].x, v[j].y); wv.y = cvt_pk_bf16(v[j].z, v[j].w); xr[64 * j] = wv; s += (v[j].x + v[j].y) + (v[j].z + v[j].w); }
            mean = wave_sum(s) * (1.f / D); s2 = 0.f;
#pragma unroll
            for (int j = 0; j < 4; ++j) { v[j] = v[j] - mean; s2 += (v[j].x * v[j].x + v[j].y * v[j].y) + (v[j].z * v[j].z + v[j].w * v[j].w); }
            rstd = 1.f / sqrtf(wave_sum(s2) * (1.f / D) + LN_EPS);
            unsigned* o4 = (unsigned*)(H2 + (size_t)m * D) + lane;
#pragma unroll
            for (int j = 0; j < 4; ++j) { const f32x4 sh = msh[j], sc = msc[j];
                v[j] = v[j] * rstd * (sc + 1.0f) + sh;
                o4[64 * j] = pk4_fp8(v[j].x, v[j].y, v[j].z, v[j].w);
                u32x2 wv; wv.x = cvt_pk_bf16(v[j].x, v[j].y); wv.y = cvt_pk_bf16(v[j].z, v[j].w);
                *(LAS u32x2*)(HT + (2 * w + rr) * RS + (4 * lane + 256 * j) * 2) = wv; }
        }
        __syncthreads();
        f32x4 acc = {0.f, 0.f, 0.f, 0.f};
#pragma unroll
        for (int ks = 0; ks < 4; ++ks) { const int kb = (128 * w + 32 * ks + 8 * (lane >> 4)) * 2;
            const bf16x8 a = *(const LAS bf16x8*)(HT + (lane & 15) * RS + kb), b = *(const LAS bf16x8*)(WT + (lane & 15) * RS + kb);
            acc = __builtin_amdgcn_mfma_f32_16x16x32_bf16(a, b, acc, 0, 0, 0); }
        RED[w * 64 + lane] = acc;
        __syncthreads();
        if (F.tid < 256) { const int r = F.tid >> 4, e = F.tid & 15, ln = (r >> 2) * 16 + e, rg = r & 3; float lg = 0.f;
#pragma unroll
            for (int ww = 0; ww < 8; ++ww) lg += RED[ww * 64 + ln][rg];
            float mx = lg;
#pragma unroll
            for (int o = 1; o < 16; o <<= 1) mx = fmaxf(mx, __shfl_xor(mx, o));
            const float ex = expf(lg - mx); float sm = ex;
#pragma unroll
            for (int o = 1; o < 16; o <<= 1) sm += __shfl_xor(sm, o);
            aff[(size_t)e * NTOK + row0 + r] = ex / sm; sel[(size_t)(row0 + r) * 16 + e] = -1; }
        __syncthreads();
    }
}

__device__ __forceinline__ unsigned wave_suffix_incl(unsigned v, int lane) {
#pragma unroll
    for (int o = 1; o < 64; o <<= 1) { const unsigned t = __shfl_down(v, o); if (lane + o < 64) v += t; }
    return v;
}
__device__ __forceinline__ unsigned wave_prefix_excl(unsigned v, int lane) {
    const unsigned own = v;
#pragma unroll
    for (int o = 1; o < 64; o <<= 1) { const unsigned t = __shfl_up(v, o); if (lane >= o) v += t; }
    return v - own;
}
template <int NJ> __device__ __forceinline__ void topk_job(Frame& F, const int g, const int e) {
    const Params& P = *F.p;
    constexpr int n = NJ * NTHREADS, cap = n / 8;
    const int base = g ? NP : 0, sbase = e * SLOTS_E + (g ? CAP_P : 0);
    LAS unsigned* hist = (LAS unsigned*)F.lds;
    LAS unsigned* misc = hist + 256;
    LAS unsigned* cgt = misc + 64;
    LAS unsigned* ceq = cgt + 256;
    const float* aff = (const float*)(P.ws + WS_AFF) + (size_t)e * NTOK + base;
    unsigned k[NJ];
#pragma unroll
    for (int j = 0; j < NJ; ++j) k[j] = __float_as_uint(aff[j * NTHREADS + F.tid]);
    unsigned prefix = 0u, mask = 0u, need = (unsigned)cap;
    for (int pass = 0; pass < 4; ++pass) {
        const int shift = 24 - 8 * pass;
        if (F.tid < 256) hist[F.tid] = 0u;
        __syncthreads();
        if (pass == 0) {
            const unsigned b0 = k[0] >> 24; unsigned cnt = 0u;
#pragma unroll
            for (int j = 0; j < NJ; ++j) { const unsigned b = k[j] >> 24; if (b == b0) ++cnt; else atomicAdd((unsigned*)&hist[b], 1u); }
            atomicAdd((unsigned*)&hist[b0], cnt);
        } else {
#pragma unroll
            for (int j = 0; j < NJ; ++j) if ((k[j] & mask) == prefix) atomicAdd((unsigned*)&hist[(k[j] >> shift) & 255u], 1u);
        }
        __syncthreads();
        unsigned mine = 0u, sfx = 0u;
        if (F.tid < 256) { mine = hist[F.tid]; sfx = wave_suffix_incl(mine, F.lane); if (F.lane == 0) misc[8 + F.wave] = sfx; }
        __syncthreads();
        if (F.tid < 256) { for (int w = F.wave + 1; w < 4; ++w) sfx += misc[8 + w];
            const unsigned above = sfx - mine;
            if (above < need && sfx >= need) { misc[0] = (unsigned)F.tid; misc[1] = need - above; } }
        __syncthreads();
        prefix |= misc[0] << shift; mask |= 255u << shift; need = misc[1];
        __syncthreads();
    }
    const unsigned T = prefix;
    int* list = (int*)(P.ws + WS_LIST); float* gate = (float*)(P.ws + WS_GATE); int* sel = (int*)(P.ws + WS_SEL);
#pragma unroll
    for (int j = 0; j < NJ; ++j) { const unsigned long long bg = __ballot(k[j] > T), be = __ballot(k[j] == T);
        if (F.lane == 0) { cgt[j * 8 + F.wave] = (unsigned)__popcll(bg); ceq[j * 8 + F.wave] = (unsigned)__popcll(be); } }
    if (F.tid >= NJ * 8 && F.tid < 256) { cgt[F.tid] = 0u; ceq[F.tid] = 0u; }
    __syncthreads();
    if (F.wave < 4) {
        const unsigned a = cgt[F.tid], b = ceq[F.tid];
        const unsigned pa = wave_prefix_excl(a, F.lane), pb = wave_prefix_excl(b, F.lane);
        if (F.lane == 63) { misc[16 + F.wave] = pa + a; misc[24 + F.wave] = pb + b; }
        __syncthreads();
        unsigned oa = 0u, ob = 0u; for (int w = 0; w < F.wave; ++w) { oa += misc[16 + w]; ob += misc[24 + w]; }
        cgt[F.tid] = pa + oa; ceq[F.tid] = pb + ob;
    } else __syncthreads();
    __syncthreads();
    const unsigned long long lt = (1ull << F.lane) - 1ull;
#pragma unroll
    for (int j = 0; j < NJ; ++j) { const int i = j * NTHREADS + F.tid;
        const bool gt = k[j] > T, eq = k[j] == T;
        const unsigned long long bg = __ballot(gt), be = __ballot(eq);
        const unsigned pg = cgt[j * 8 + F.wave] + (unsigned)__popcll(bg & lt), pe = ceq[j * 8 + F.wave] + (unsigned)__popcll(be & lt);
        if (gt || (eq && pe < need)) { const int slot = sbase + (int)(pg + (pe < need ? pe : need));
            list[slot] = base + i; gate[slot] = __uint_as_float(k[j]); sel[(size_t)(base + i) * 16 + e] = slot; } }
}
__device__ __forceinline__ void p8_topk(Frame& F) {
    const Params& P = *F.p;
    if (F.vcu < 32) {
        if (F.tid == 0) {
            unsigned* c = (unsigned*)(P.ws + WS_CTL) + 320; unsigned spins = 0;
            while (__hip_atomic_load(c, __ATOMIC_RELAXED, __HIP_MEMORY_SCOPE_AGENT) < (unsigned)F.G) { __builtin_amdgcn_s_sleep(4); if (++spins > (1u << 24)) break; }
            __builtin_amdgcn_fence(__ATOMIC_ACQUIRE, "agent"); asm volatile("s_waitcnt vmcnt(0)" ::: "memory");
        }
        __syncthreads();
        if (F.vcu < 16) topk_job<NP / NTHREADS>(F, 0, F.vcu); else topk_job<NS / NTHREADS>(F, 1, F.vcu - 16);
    } else {
        unsigned* ctr = (unsigned*)(P.ws + WS_CTL); LAS unsigned* slot = (LAS unsigned*)(F.lds + LDS_BYTES - 64);
        for (;;) {
            if (F.tid == 0) *slot = atomicAdd(ctr + 192, 4u);
            __syncthreads();
            const int b0 = CONV_P3 + (int)*slot;
            __syncthreads();
            if (b0 >= CONV_TOTAL) break;
            conv_batch(P, F.lds, F.tid, b0, 4);
        }
    }
}

struct SchedMoe1 {
    struct U { int e, mt, nt_, i; };
    const char* A; const char* B; const LAS int* lrow; int lda, ldb, nt, G, c;
    __device__ __forceinline__ bool next(int i, U& u) const { const int L = i * G + c; if (L >= 3520) return false; u.e = L / 220; const int r = L % 220; u.mt = r % 10; u.nt_ = r / 10; u.i = i; return true; }
    __device__ __forceinline__ int nt_u(const U&) const { return nt; }
    __device__ __forceinline__ const char* a_base(const U&) const { return A; }
    __device__ __forceinline__ unsigned a_row(const U& u, int r) const { return (unsigned)lrow[u.i * 256 + r]; }
    __device__ __forceinline__ const char* b_base(const U& u) const { return B + ((size_t)u.e * 5632 + (size_t)u.nt_ * 256) * ldb; }
};
struct EpiMoe1 {
    static constexpr bool HAS_MID = false;
    unsigned char* HID;
    __device__ __forceinline__ void operator()(const f32x4 (&acc)[2][2][4][2], const SchedMoe1::U& u, int wr, int wc, int fr, int fq) const {
        const int row0 = u.e * SLOTS_E + u.mt * 256 + wr * 64 + fr, col0 = u.nt_ * 128 + wc * 32 + 8 * fq;
        constexpr float IS = 1.0f / S_W1;
#pragma unroll
        for (int ai = 0; ai < 2; ++ai)
#pragma unroll
            for (int m = 0; m < 4; ++m) {
                float t[8];
#pragma unroll
                for (int n = 0; n < 2; ++n)
#pragma unroll
                    for (int j = 0; j < 4; ++j) t[4 * n + j] = siluf_(acc[ai][0][m][n][j] * IS) * (acc[ai][1][m][n][j] * (IS * S_HID));
                u32x2 w; w.x = pk4_fp8(t[0], t[1], t[2], t[3]); w.y = pk4_fp8(t[4], t[5], t[6], t[7]);
                *(u32x2*)(HID + (size_t)(row0 + ai * 128 + m * 16) * FF + col0) = w;
            }
    }
};

constexpr int YE2_SLOT0 = 12 * SLOTS_E + 8 * 256;
constexpr size_t WS_YE2 = WS_WGU + (size_t)140 * 1024 * 1024;
static_assert(WS_YE2 >= WS_WD + (size_t)16 * 1024 * FF && WS_YE2 + (size_t)(NSLOT - YE2_SLOT0) * 1024 * 2 <= WS_A, "ye2 placement");
struct SchedMoe2 {
    struct U { int e, mt, n2, ks, nt; };
    const char* A; const char* B; int lda, ldb, G, c;
    __device__ __forceinline__ bool next(int i, U& u) const {
        if (i > 2) return false;
        int L;
        if (i < 2) { L = i * G + c; u.ks = 0; u.nt = 22; } else { L = 2 * G + (c >> 1); u.ks = c & 1; u.nt = u.ks ? 10 : 12; }
        if (L >= 640) return false;
        u.n2 = L & 3; const int mg = L >> 2; u.e = mg / 10; u.mt = mg % 10; return true; }
    __device__ __forceinline__ int nt_u(const U& u) const { return u.nt; }
    __device__ __forceinline__ const char* a_base(const U& u) const { return A + (size_t)u.ks * 1536; }
    __device__ __forceinline__ unsigned a_row(const U& u, int r) const { return (unsigned)(u.e * SLOTS_E + u.mt * 256 + r); }
    __device__ __forceinline__ const char* b_base(const U& u) const { return B + ((size_t)u.e * 1024 + (size_t)u.n2 * 256) * ldb + (size_t)u.ks * 1536; }
};
struct EpiMoe2 {
    static constexpr bool HAS_MID = false;
    bf16_t* YE; bf16_t* YE2; const float* gate;
    __device__ __forceinline__ void operator()(const f32x4 (&acc)[2][2][4][2], const SchedMoe2::U& u, int wr, int wc, int fr, int fq) const {
        const int row0 = u.e * SLOTS_E + u.mt * 256 + wr * 64 + fr, col0 = u.n2 * 256 + wc * 32 + 8 * fq;
        unsigned char* Y = u.ks ? (unsigned char*)YE2 - (size_t)YE2_SLOT0 * 1024 : (unsigned char*)YE;
#pragma unroll
        for (int ai = 0; ai < 2; ++ai)
#pragma unroll
            for (int m = 0; m < 4; ++m) { const int row = row0 + ai * 128 + m * 16; const float gt = gate[row] * (S_YE / (S_HID * S_W2));
#pragma unroll
                for (int bj = 0; bj < 2; ++bj) { const f32x4 v0 = acc[ai][bj][m][0] * gt, v1 = acc[ai][bj][m][1] * gt;
                    u32x2 w; w.x = pk4_fp8(v0.x, v0.y, v0.z, v0.w); w.y = pk4_fp8(v1.x, v1.y, v1.z, v1.w);
                    *(u32x2*)(Y + (size_t)row * 1024 + col0 + bj * 128) = w; } }
    }
};

template <class SyncF> __device__ __forceinline__ void p11_final(Frame& F, SyncF&& sync) {
    const Params& P = *F.p;
    const float* mod = (const float*)(P.ws + WS_MOD); const int* sel = (const int*)(P.ws + WS_SEL);
    const unsigned char* Y8 = (const unsigned char*)(P.ws + WS_YE); const unsigned char* Y82 = (const unsigned char*)(P.ws + WS_YE2);
    const int gw = F.vcu * NWAVES + F.wave, NGW = F.G * NWAVES, lane = F.lane;
    const bf16_t* X1B = (const bf16_t*)(P.ws + WS_X1B);
    LAS f32x4* MG2L = (LAS f32x4*)F.lds;
    LAS int* SELW = (LAS int*)(F.lds + 9 * 4096) + F.wave * (16 * 192);
    const int nrow = (gw < NTOK) ? (NTOK - gw + NGW - 1) / NGW : 0;
    f32x4 lg[4], lb[4];
#define P11_SLOTS(SN, S0, S1) do { const unsigned mk_ = (unsigned)(__ballot((SN) >= 0) & 0xffffull), m2_ = mk_ & (mk_ - 1u); \
        const int r0_ = __builtin_amdgcn_readlane((SN), mk_ ? __builtin_ctz(mk_) : 0), r1_ = __builtin_amdgcn_readlane((SN), m2_ ? __builtin_ctz(m2_) : 0); \
        S0 = mk_ ? r0_ : -1; S1 = m2_ ? r1_ : -1; } while (0)
#define P11_GATHER(SN, A, A2) do { int s0_, s1_; P11_SLOTS(SN, s0_, s1_); \
        const size_t o0_ = (size_t)(s0_ < 0 ? 0 : s0_) * 1024, o1_ = (size_t)(s1_ < 0 ? 0 : s1_) * 1024, q0_ = (size_t)(s0_ < YE2_SLOT0 ? 0 : s0_ - YE2_SLOT0) * 1024, q1_ = (size_t)(s1_ < YE2_SLOT0 ? 0 : s1_ - YE2_SLOT0) * 1024; \
        _Pragma("unroll") for (int j = 0; j < 4; ++j) { A[0][j] = *(const unsigned*)(Y8 + o0_ + 4 * lane + 256 * j); A[1][j] = *(const unsigned*)(Y8 + o1_ + 4 * lane + 256 * j); \
            A2[0][j] = *(const unsigned*)(Y82 + q0_ + 4 * lane + 256 * j); A2[1][j] = *(const unsigned*)(Y82 + q1_ + 4 * lane + 256 * j); } } while (0)
    u32x2 xn[4];
    unsigned Aa[2][4], A2a[2][4], Ab[2][4], A2b[2][4];
    sync([&]() {
    { f32x4 t[5];
#pragma unroll
      for (int u = 0; u < 5; ++u) { const int q = F.tid + NTHREADS * u; if (q < 9 * 256) t[u] = *((const f32x4*)(mod + (q >> 8) * 6144 + 5120) + (q & 255)); }
      if (nrow > 0) { int sv[4];
#pragma unroll
        for (int u = 0; u < 4; ++u) { const int k = 4 * u + (lane >> 4), kc = (k < nrow) ? k : nrow - 1; sv[u] = sel[(size_t)(gw + kc * NGW) * 16 + (lane & 15)]; }
#pragma unroll
        for (int u = 0; u < 4; ++u) { const int k = 4 * u + (lane >> 4); if (k < nrow) SELW[k * 16 + (lane & 15)] = sv[u]; } }
      for (int k0 = 16; k0 < nrow; k0 += 4) { const int k = k0 + (lane >> 4); if (k < nrow) SELW[k * 16 + (lane & 15)] = sel[(size_t)(gw + k * NGW) * 16 + (lane & 15)]; }
#pragma unroll
      for (int u = 0; u < 5; ++u) { const int q = F.tid + NTHREADS * u; if (q < 9 * 256) MG2L[q] = t[u]; } }
    __syncthreads();
#pragma unroll
    for (int j = 0; j < 4; ++j) { lg[j] = *((const f32x4*)P.in[I_LN2G] + lane + 64 * j); lb[j] = *((const f32x4*)P.in[I_LN2B] + lane + 64 * j); }
    if (nrow > 0) {
#pragma unroll
        for (int j = 0; j < 4; ++j) xn[j] = *((const u32x2*)(X1B + (size_t)gw * D) + lane + 64 * j); }
    });
    if (nrow > 0) { const int s0r = SELW[lane & 15];
        P11_GATHER(s0r, Aa, A2a); }
#define P11_ROW(K, AC, A2C, AN, A2N) do { const int k_ = (K), m = gw + k_ * NGW; \
        f32x4 v[4], mo[4]; \
        _Pragma("unroll") for (int j = 0; j < 4; ++j) v[j] = (f32x4){bflo(xn[j].x), bfhi(xn[j].x), bflo(xn[j].y), bfhi(xn[j].y)}; \
        const int myslot = SELW[k_ * 16 + (lane & 15)]; \
          \
        const int kn_ = (k_ + 1 < nrow) ? k_ + 1 : k_; \
        _Pragma("unroll") for (int j = 0; j < 4; ++j) xn[j] = *((const u32x2*)(X1B + (size_t)(gw + kn_ * NGW) * D) + lane + 64 * j);     \
        asm volatile("" ::: "memory"); \
        { const int sn_ = SELW[kn_ * 16 + (lane & 15)]; P11_GATHER(sn_, AN, A2N); } \
        int c0, c1; P11_SLOTS(myslot, c0, c1); \
        const float k0 = (c0 >= 0) ? 1.f : 0.f, k1 = (c1 >= 0) ? 1.f : 0.f, k20 = (c0 >= YE2_SLOT0) ? 1.f : 0.f, k21 = (c1 >= YE2_SLOT0) ? 1.f : 0.f; \
        _Pragma("unroll") for (int j = 0; j < 4; ++j) mo[j] = (fp8x4_f32(AC[0][j]) * k0 + fp8x4_f32(A2C[0][j]) * k20) + (fp8x4_f32(AC[1][j]) * k1 + fp8x4_f32(A2C[1][j]) * k21); \
        unsigned mask = (unsigned)(__ballot(myslot >= 0) & 0xffffull); mask &= mask - 1u; mask &= mask - 1u; \
        while (mask) {                                                 \
            const int e0 = __builtin_ctz(mask); mask &= mask - 1u; \
            const int s0 = __builtin_amdgcn_readlane(myslot, e0); \
            int s1 = -1; if (mask) { const int e1 = __builtin_ctz(mask); mask &= mask - 1u; s1 = __builtin_amdgcn_readlane(myslot, e1); } \
            unsigned a[2][4], a2[2][4]; \
            _Pragma("unroll") for (int j = 0; j < 4; ++j) { a[0][j] = *(const unsigned*)(Y8 + (size_t)s0 * 1024 + 4 * lane + 256 * j); \
                a[1][j] = (s1 >= 0) ? *(const unsigned*)(Y8 + (size_t)s1 * 1024 + 4 * lane + 256 * j) : 0u; } \
            _Pragma("unroll") for (int j = 0; j < 4; ++j) { a2[0][j] = (s0 >= YE2_SLOT0) ? *(const unsigned*)(Y82 + (size_t)(s0 - YE2_SLOT0) * 1024 + 4 * lane + 256 * j) : 0u; \
                a2[1][j] = (s1 >= YE2_SLOT0) ? *(const unsigned*)(Y82 + (size_t)(s1 - YE2_SLOT0) * 1024 + 4 * lane + 256 * j) : 0u; } \
            _Pragma("unroll") for (int q = 0; q < 2; ++q) _Pragma("unroll") for (int j = 0; j < 4; ++j) mo[j] = mo[j] + (fp8x4_f32(a[q][j]) + fp8x4_f32(a2[q][j])); \
        } \
        float s = 0.f; \
        _Pragma("unroll") for (int j = 0; j < 4; ++j) { const f32x4 g = MG2L[mod_row(m) * 256 + lane + 64 * j] * (1.0f / S_YE); v[j] = v[j] * ALPHA + g * mo[j]; s += (v[j].x + v[j].y) + (v[j].z + v[j].w); } \
        const float mean = wave_sum(s) * (1.f / D); float s2 = 0.f; \
        _Pragma("unroll") for (int j = 0; j < 4; ++j) { v[j] = v[j] - mean; s2 += (v[j].x * v[j].x + v[j].y * v[j].y) + (v[j].z * v[j].z + v[j].w * v[j].w); } \
        const float rstd = 1.f / sqrtf(wave_sum(s2) * (1.f / D) + LN_EPS); \
        f32x4* xr = (f32x4*)(P.out + (size_t)m * D) + lane; \
        _Pragma("unroll") for (int j = 0; j < 4; ++j) xr[64 * j] = v[j] * rstd * lg[j] + lb[j]; } while (0)
    for (int k = 0; k < nrow; k += 2) {
        P11_ROW(k, Aa, A2a, Ab, A2b);
        if (k + 1 < nrow) P11_ROW(k + 1, Ab, A2b, Aa, A2a);
    }
#undef P11_ROW
#undef P11_GATHER
#undef P11_SLOTS
}

#define XB_TMO      128
#define XB_XCNT(j)  (256  + 64 * (j))
#define XB_XSUB(j)  (1280 + 64 * (j))
#define XB_XGEN(j)  (2304 + 64 * (j))
#define XB_TOP      3328
#define XB_TOPGEN   3392
#define XCD_BAR_WORDS 3456
#define XB_SPIN_CAP (1u << 22)
__device__ __forceinline__ unsigned xb_ld(unsigned* p)              { return __hip_atomic_load(p, __ATOMIC_RELAXED, __HIP_MEMORY_SCOPE_AGENT); }
__device__ __forceinline__ unsigned xb_add(unsigned* p, unsigned v) { return __hip_atomic_fetch_add(p, v, __ATOMIC_RELAXED, __HIP_MEMORY_SCOPE_AGENT); }
__device__ __forceinline__ unsigned xb_xcc_id() { return (unsigned)__builtin_amdgcn_s_getreg((3 << 11) | 20) & 0xFu; }
#define XB_SPIN(cond, bar) do { unsigned _sp = 0; while (cond) { __builtin_amdgcn_s_sleep(1); \
    if ((++_sp & 255u) == 0u) { if (xb_ld(&(bar)[XB_TMO])) break; if (_sp > XB_SPIN_CAP) { atomicAdd(&(bar)[XB_TMO], 1u); break; } } } } while (0)
struct XcdBarrier { unsigned* bar; unsigned x; volatile LAS unsigned* st; };
__device__ __forceinline__ XcdBarrier xcd_barrier_post(unsigned* bar, volatile LAS unsigned* st) {
    XcdBarrier b; b.bar = bar; b.x = xb_xcc_id(); b.st = st;
    if (threadIdx.x == 0) (void)xb_add(&bar[XB_XCNT(b.x)], 1u);
    return b;
}
__device__ __forceinline__ void xcd_barrier_complete(unsigned* bar, unsigned x, unsigned& nloc, unsigned& nx) {
    const unsigned G = gridDim.x * gridDim.y * gridDim.z;
    unsigned sum, cnt, mine, sp = 0u;
    for (;;) {
        sum = 0u; cnt = 0u; mine = 0u;
#pragma unroll
        for (unsigned j = 0; j < 16; ++j) { const unsigned c = xb_ld(&bar[XB_XCNT(j)]); sum += c; cnt += (c > 0u) ? 1u : 0u; mine = (j == x) ? c : mine; }
        if (sum == G) break;
        __builtin_amdgcn_s_sleep(1);
        if ((++sp & 255u) == 0u) { if (xb_ld(&bar[XB_TMO])) break; if (sp > XB_SPIN_CAP) { atomicAdd(&bar[XB_TMO], 1u); break; } }
    }
    nloc = mine > 0u ? mine : 1u; nx = cnt > 0u ? cnt : 1u;
}
__device__ __forceinline__ void xcd_barrier(const XcdBarrier& b) {
    asm volatile("s_waitcnt vmcnt(0)" ::: "memory");
    __syncthreads();
    if (threadIdx.x == 0) {
        unsigned* bar = b.bar;
        __builtin_amdgcn_s_waitcnt(0);
        unsigned nloc = b.st[0], nx = b.st[1];
        if (nloc == 0u) { xcd_barrier_complete(bar, b.x, nloc, nx); b.st[0] = nloc; b.st[1] = nx; }
        const unsigned old = xb_add(&bar[XB_XSUB(b.x)], 1u);
        const unsigned gen = old / nloc;
        if (old + 1u == (gen + 1u) * nloc) {
            __builtin_amdgcn_fence(__ATOMIC_RELEASE, "agent");
            asm volatile("s_waitcnt vmcnt(0)" ::: "memory");
            const unsigned og = xb_add(&bar[XB_TOP], 1u);
            const unsigned tg = og / nx;
            if (og + 1u == (tg + 1u) * nx) xb_add(&bar[XB_TOPGEN], 1u);
            else XB_SPIN(xb_ld(&bar[XB_TOPGEN]) == tg, bar);
            __builtin_amdgcn_fence(__ATOMIC_ACQUIRE, "agent");
            xb_add(&bar[XB_XGEN(b.x)], 1u);
            asm volatile("s_waitcnt vmcnt(0)" ::: "memory");
        } else {
            XB_SPIN(xb_ld(&bar[XB_XGEN(b.x)]) == gen, bar);
            __builtin_amdgcn_fence(__ATOMIC_ACQUIRE, "agent");
            asm volatile("s_waitcnt vmcnt(0)" ::: "memory");
        }
    }
    __syncthreads();
}

template <class PreF> __device__ __forceinline__ void xcd_barrier_pre(const XcdBarrier& b, PreF&& pre) {
    asm volatile("s_waitcnt vmcnt(0)" ::: "memory");
    __syncthreads();
    unsigned gen = 0u, tg = 0u; bool leader = false, toplast = false;
    if (threadIdx.x == 0) {
        unsigned* bar = b.bar;
        __builtin_amdgcn_s_waitcnt(0);
        unsigned nloc = b.st[0], nx = b.st[1];
        if (nloc == 0u) { xcd_barrier_complete(bar, b.x, nloc, nx); b.st[0] = nloc; b.st[1] = nx; }
        const unsigned old = xb_add(&bar[XB_XSUB(b.x)], 1u);
        gen = old / nloc;
        leader = (old + 1u == (gen + 1u) * nloc);
        if (leader) {
            __builtin_amdgcn_fence(__ATOMIC_RELEASE, "agent");
            asm volatile("s_waitcnt vmcnt(0)" ::: "memory");
            const unsigned og = xb_add(&bar[XB_TOP], 1u);
            tg = og / nx;
            toplast = (og + 1u == (tg + 1u) * nx);
            if (toplast) xb_add(&bar[XB_TOPGEN], 1u);
        }
    }
    pre();
    if (threadIdx.x == 0) {
        unsigned* bar = b.bar;
        if (leader) {
            if (!toplast) XB_SPIN(xb_ld(&bar[XB_TOPGEN]) == tg, bar);
            __builtin_amdgcn_fence(__ATOMIC_ACQUIRE, "agent");
            xb_add(&bar[XB_XGEN(b.x)], 1u);
            asm volatile("s_waitcnt vmcnt(0)" ::: "memory");
        } else {
            XB_SPIN(xb_ld(&bar[XB_XGEN(b.x)]) == gen, bar);
            __builtin_amdgcn_fence(__ATOMIC_ACQUIRE, "agent");
            asm volatile("s_waitcnt vmcnt(0)" ::: "memory");
        }
    }
    __syncthreads();
}

__global__ void __launch_bounds__(NTHREADS, 2) mega_fwd(Params P) {
    extern __shared__ __attribute__((aligned(16))) unsigned char lds_raw[];
    Frame F;
    F.lds = (LAS unsigned char*)lds_raw; F.tid = threadIdx.x; F.lane = F.tid & 63; F.wave = __builtin_amdgcn_readfirstlane(F.tid >> 6);
    F.G = gridDim.x; { const int bx = blockIdx.x; F.vcu = (F.G % 8 == 0) ? (bx % 8) * (F.G / 8) + bx / 8 : bx; }
    F.p = &P;
    {
        volatile LAS unsigned* st = (volatile LAS unsigned*)(F.lds + LDS_BYTES - 32);
        if (F.tid == 0) { st[0] = 0u; st[1] = 0u; }
        __syncthreads();
    }
    XcdBarrier xbar = xcd_barrier_post((unsigned*)(P.ws + WS_CTL + 16384), (volatile LAS unsigned*)(F.lds + LDS_BYTES - 32));
#ifdef DBG_STAMP
#define STAMP(K) do { if (((K) == DBG_STAMP || (K) == DBG_STAMP + 1) && blockIdx.x == 0 && F.tid == 0) ((unsigned long long*)(P.ws + WS_CTL + 32768))[K] = __builtin_amdgcn_s_memrealtime(); } while (0)
#else
#define STAMP(K) do {} while (0)
#endif
    STAMP(0);
#define GRID_LAUNDER() do { int t_ = threadIdx.x; asm volatile("" : "+v"(t_)); F.tid = t_; F.lane = t_ & 63; F.wave = __builtin_amdgcn_readfirstlane(t_ >> 6); int v_ = F.vcu; asm volatile("" : "+s"(v_)); F.vcu = v_; } while (0)
#define GRID_SYNC(K) do { xcd_barrier(xbar); STAMP((K) + 1); int t_ = threadIdx.x; asm volatile("" : "+v"(t_)); F.tid = t_; F.lane = t_ & 63; F.wave = __builtin_amdgcn_readfirstlane(t_ >> 6); \
        int v_ = F.vcu; asm volatile("" : "+s"(v_)); F.vcu = v_; } while (0)

#ifndef DBG_DOUBLE
#define DBG_DOUBLE -1
#endif
#ifndef ONLY_PHASE
#define ONLY_PHASE -1
#endif
#define REPS(k) ((ONLY_PHASE >= 0 && ONLY_PHASE != (k)) ? 0 : ((DBG_DOUBLE == (k)) ? 2 : 1))
    for (int rep = 0; rep < REPS(0); ++rep) {
    p0_prologue(F);
    GRID_SYNC(0);
    }
    for (int rep = 0; rep < REPS(1); ++rep) {
    p1_ln0(F);
    GRID_SYNC(1);
    }
    for (int rep = 0; rep < REPS(2); ++rep) {
    {
        SchedIn S{(const char*)P.out, (const char*)(P.ws + WS_WIN), 1024, 1024, 16, F.G, (int)blockIdx.x};
        EpiIn E{P.ws, P.out, (const float*)(P.ws + WS_ROPE), 1.0f};
        pg8::gemm_phase(F.lds, S, E, F.tid, (DBG_GPROF == 2) ? (unsigned long long*)(P.ws + WS_CTL + 40960) : nullptr);
        SchedIn8 S8{(const char*)P.out + H8_OFF, (const char*)(P.ws + WS_WIN8), 1024, 1024, 8, F.G, (int)blockIdx.x};
        EpiIn E8{P.ws, P.out, (const float*)(P.ws + WS_ROPE), 1.0f / S_WIN};
        pg8::gemm_phase<SchedIn8, EpiIn, true>(F.lds, S8, E8, F.tid);
    }
    GRID_SYNC(2);
    }
    for (int rep = 0; rep < REPS(3); ++rep) {
    p3_mixers(F, rep);
    }
    for (int rep = 0; rep < REPS(5); ++rep) {
    {
        GRID_LAUNDER();
        SchedMrg S{(const char*)(P.ws + WS_OCAT), (const char*)(P.ws + WS_WA), 2048, 2048, 16, F.G, F.vcu};
        EpiMrg E{(const bf16_t*)(P.ws + WS_GA), (const bf16_t*)(P.ws + WS_GB), (bf16_t*)(P.ws + WS_MRG), P.ws};
        auto bar3 = [&](auto&& pre) { xcd_barrier_pre(xbar, pre); STAMP(4); };
        pg8::gemm_phase<SchedMrg, EpiMrg, true>(F.lds, S, E, F.tid, (DBG_GPROF == 5) ? (unsigned long long*)(P.ws + WS_CTL + 40960) : nullptr, &bar3);
    }
    }
    for (int rep = 0; rep < REPS(6); ++rep) {
    {
        GRID_LAUNDER();
        SchedOut S{(const char*)P.ws, (const char*)(P.ws + WS_WO), 1024, 2048, 8, F.G, F.vcu};
        EpiOut E{(bf16_t*)(P.ws + WS_MIX), (bf16_t*)(P.ws + WS_MIX2)};
        auto bar5 = [&](auto&& pre) { xcd_barrier_pre(xbar, pre); STAMP(6); };
        pg8::gemm_phase<SchedOut, EpiOut, true>(F.lds, S, E, F.tid, (DBG_GPROF == 6) ? (unsigned long long*)(P.ws + WS_CTL + 40960) : nullptr, &bar5);
    }
    }
    for (int rep = 0; rep < REPS(7); ++rep) {
    p7_ln1_router(F, [&](auto&& pre) { xcd_barrier_pre(xbar, pre); STAMP(7); GRID_LAUNDER(); });
    asm volatile("s_waitcnt vmcnt(0)" ::: "memory"); __syncthreads();
    if (F.tid == 0) { __builtin_amdgcn_fence(__ATOMIC_RELEASE, "agent"); asm volatile("s_waitcnt vmcnt(0)" ::: "memory");
        __hip_atomic_fetch_add((unsigned*)(P.ws + WS_CTL) + 320 + rep, 1u, __ATOMIC_RELAXED, __HIP_MEMORY_SCOPE_AGENT); }
    { int t_ = threadIdx.x; asm volatile("" : "+v"(t_)); F.tid = t_; F.lane = t_ & 63; F.wave = __builtin_amdgcn_readfirstlane(t_ >> 6); int v_ = F.vcu; asm volatile("" : "+s"(v_)); F.vcu = v_; }
    }
    for (int rep = 0; rep < REPS(8); ++rep) {
    p8_topk(F);
    GRID_SYNC(8);
    }
    for (int rep = 0; rep < REPS(9); ++rep) {
    {
        LAS int* lrow = (LAS int*)(F.lds + 131072);
        { const int* list = (const int*)(P.ws + WS_LIST);
          for (int q = F.tid; q < 14 * 256; q += NTHREADS) { const int i = q >> 8, L = i * F.G + F.vcu; if (L < 3520) { const int e = L / 220, mt = (L % 220) % 10; lrow[q] = list[e * SLOTS_E + mt * 256 + (q & 255)]; } }
          __syncthreads(); }
        SchedMoe1 S{(const char*)(P.ws + WS_H2), (const char*)(P.ws + WS_WGU), lrow, 1024, 1024, 8, F.G, F.vcu};
        EpiMoe1 E{(unsigned char*)(P.ws + WS_HID)};
        pg8::gemm_phase<SchedMoe1, EpiMoe1, true>(F.lds, S, E, F.tid, (DBG_GPROF == 9) ? (unsigned long long*)(P.ws + WS_CTL + 40960) : nullptr);
    }
    }
    for (int rep = 0; rep < REPS(10); ++rep) {
    {
        GRID_LAUNDER();
        SchedMoe2 S{(const char*)(P.ws + WS_HID), (const char*)(P.ws + WS_WD), FF, FF, F.G, F.vcu};
        EpiMoe2 E{(bf16_t*)(P.ws + WS_YE), (bf16_t*)(P.ws + WS_YE2), (const float*)(P.ws + WS_GATE)};
        auto bar9 = [&](auto&& pre) { xcd_barrier_pre(xbar, pre); STAMP(10); };
        pg8::gemm_phase<SchedMoe2, EpiMoe2, true>(F.lds, S, E, F.tid, (DBG_GPROF == 10) ? (unsigned long long*)(P.ws + WS_CTL + 40960) : nullptr, &bar9);
    }
    }
    if (ONLY_PHASE < 0 || ONLY_PHASE == 11) p11_final(F, [&](auto&& pre) { xcd_barrier_pre(xbar, pre); STAMP(11); GRID_LAUNDER(); }); else { GRID_SYNC(10); }
#ifdef DBG_STAMP
    GRID_SYNC(11);
    {
        const unsigned long long* ts = (const unsigned long long*)(P.ws + WS_CTL + 32768);
        const float us = (DBG_GPROF >= 0) ? (float)(((const unsigned long long*)(P.ws + WS_CTL + 40960))[DBG_GQ]) * 0.01f : (float)(ts[DBG_STAMP + 1] - ts[DBG_STAMP]) * 0.01f;
        for (size_t i = (size_t)blockIdx.x * NTHREADS + F.tid; i < O_YS; i += (size_t)F.G * NTHREADS) P.out[i] += DBG_C * us;
    }
#endif
#ifdef DBG_ZERO_MASK
    GRID_SYNC(12);
    {
        const size_t starts[7] = {O_YP, O_YS, O_NK, O_NV, O_NF, O_NB, O_END};
        for (int o = 0; o < 6; ++o) if ((DBG_ZERO_MASK >> o) & 1)
            for (size_t i = starts[o] + (size_t)blockIdx.x * NTHREADS + F.tid; i < starts[o + 1]; i += (size_t)F.G * NTHREADS) P.out[i] = 0.f;
    }
#endif
}

extern "C" void kernel_launch(void* const* d_in, const int* in_sizes, int n_in, void* d_out, int out_size, void* d_ws, size_t ws_size, hipStream_t stream) {
    static int grid = 0;
    if (grid == 0) {
        if (n_in != 32 || out_size != (int)O_END || ws_size < WS_END) { fprintf(stderr, "kernel_launch: unexpected shapes: n_in %d out %d ws %zu (need %zu)\n", n_in, out_size, ws_size, (size_t)WS_END); grid = -1; return; }
        int dev = 0, cus = 0, per_cu = 0;
        if (hipGetDevice(&dev) != hipSuccess || hipDeviceGetAttribute(&cus, hipDeviceAttributeMultiprocessorCount, dev) != hipSuccess) { grid = -1; return; }
        if (hipFuncSetAttribute((const void*)mega_fwd, hipFuncAttributeMaxDynamicSharedMemorySize, LDS_BYTES) != hipSuccess) { fprintf(stderr, "kernel_launch: hipFuncSetAttribute failed\n"); grid = -1; return; }
        if (hipOccupancyMaxActiveBlocksPerMultiprocessor(&per_cu, (const void*)mega_fwd, NTHREADS, LDS_BYTES) != hipSuccess || per_cu < 1) { fprintf(stderr, "kernel_launch: occupancy query says %d\n", per_cu); per_cu = 1; }
        (void)hipGetLastError();
        if (cus < 256) { fprintf(stderr, "kernel_launch: this kernel's static phase schedules need 256 CUs (found %d)\n", cus); grid = -1; return; }
        grid = 256;
    }
    if (grid < 0) return;
    (void)hipMemsetAsync((char*)d_ws + WS_CTL, 0, 65536, stream);
    Params p{};
    for (int i = 0; i < 32; ++i) p.in[i] = (const float*)d_in[i];
    p.out = (float*)d_out; p.ws = (unsigned char*)d_ws;
    hipLaunchKernelGGL(mega_fwd, dim3(grid), dim3(NTHREADS), LDS_BYTES, stream, p);
    hipError_t e = hipPeekAtLastError();
    if (e != hipSuccess) fprintf(stderr, "kernel_launch: launch failed: %s (grid %d)\n", hipGetErrorString(e), grid);
}
```
